# Optimizing an MI355X kernel written in HIP

```python
import math
import jax
import jax.numpy as jnp
from jax import lax
import numpy as np

D_MODEL = 2048
BATCH = 16
SEQ = 256
DEPTH = 2
DEC_BATCH = 2
DEC_SEQ = 1024
PAST_LEN = 512

GRID_W = 64
N_BRANCH = 4
BRANCH_W = 512
GDN_H = 4
GDN_DK = 128
GDN_DV = 128
GDN_CONV = 5
DELTA_CHUNK = 64
GLA_H = 4
GLA_DK = 64
GLA_DV = 128
GLA_RANK = 16
GLA_TAU = 16.0
GLA_CHUNK = 16
HG_H = 4
HG_DK = 128
HG_DV = 128
MLA_H = 4
MLA_NOPE = 128
MLA_ROPE = 64
MLA_V = 128
Q_LORA = 512
KV_LORA = 512
ATTN_QBLOCK = 128
ROPE_BASE = 10000.0
D_FF = ((8 * D_MODEL // 3 + 255) // 256) * 256
NORM_EPS = 1e-6

IN_SPLITS = (
    ('gdn_q', GDN_H * GDN_DK), ('gdn_k', GDN_H * GDN_DK), ('gdn_v', GDN_H * GDN_DV),
    ('gdn_z', GDN_H * GDN_DV), ('gdn_b', 2 * GDN_H), ('gdn_a', 2 * GDN_H),
    ('gla_q', GLA_H * GLA_DK), ('gla_k', GLA_H * GLA_DK), ('gla_v', GLA_H * GLA_DV),
    ('gla_r', GLA_H * GLA_DV), ('gla_g', 2 * GLA_RANK),
    ('hg_q', HG_H * HG_DK), ('hg_f', 2 * HG_H * HG_DK), ('hg_i', HG_H * HG_DV),
    ('hg_g', HG_H * HG_DV),
    ('mla_qa', Q_LORA), ('mla_kva', KV_LORA), ('mla_kpe', MLA_ROPE),
    ('gates', N_BRANCH * D_MODEL),
)
IN_WIDTH = sum(n for _, n in IN_SPLITS)
GDN_QKV = 2 * GDN_H * GDN_DK + GDN_H * GDN_DV

kernel_name = 'hybrid_diffusion_step'


def _split_in(p):
    out, off = {}, 0
    for name, n in IN_SPLITS:
        out[name] = p[..., off:off + n]
        off += n
    return out


def _rmsnorm(x, w):
    xf = x.astype(jnp.float32)
    y = xf * lax.rsqrt(jnp.mean(xf * xf, axis=-1, keepdims=True) + NORM_EPS)
    return (y * w.astype(jnp.float32)).astype(x.dtype)


def _layernorm(x, g, b):
    xf = x.astype(jnp.float32)
    mu = jnp.mean(xf, axis=-1, keepdims=True)
    var = jnp.mean(jnp.square(xf - mu), axis=-1, keepdims=True)
    y = (xf - mu) * lax.rsqrt(var + NORM_EPS) * g.astype(jnp.float32) + b.astype(jnp.float32)
    return y.astype(x.dtype)


def _l2norm(x):
    xf = x.astype(jnp.float32)
    return (xf * lax.rsqrt(jnp.sum(xf * xf, axis=-1, keepdims=True) + NORM_EPS)).astype(x.dtype)


def _heads(x, h):
    b, l, _ = x.shape
    return x.reshape(b, l, h, -1).transpose(0, 2, 1, 3)


def _merge_heads(x):
    b, h, l, d = x.shape
    return x.transpose(0, 2, 1, 3).reshape(b, l, h * d)


def _flip(x):
    return jnp.flip(x, axis=2)


def _centred_conv(x, w):
    pad = w.shape[0] // 2
    return lax.conv_general_dilated(
        x, w[:, None, :].astype(x.dtype), window_strides=(1,), padding=((pad, pad),),
        dimension_numbers=('NWC', 'WIO', 'NWC'), feature_group_count=x.shape[-1])


def _axial_angles(length):
    rows = length // GRID_W
    pos = jnp.arange(rows * GRID_W)
    row_id = (pos // GRID_W).astype(jnp.float32)
    col_id = (pos % GRID_W).astype(jnp.float32)
    half = MLA_ROPE // 2
    inv = ROPE_BASE ** (-jnp.arange(0, half, 2, dtype=jnp.float32) / half)
    return row_id[:, None] * inv, col_id[:, None] * inv


def _rotate(x, ang):
    m = x.shape[-1] // 2
    x1, x2 = x[..., :m], x[..., m:]
    cos, sin = jnp.cos(ang), jnp.sin(ang)
    return jnp.concatenate([x1 * cos - x2 * sin, x1 * sin + x2 * cos], axis=-1)


def _axial_rope(x, ang_row, ang_col):
    half = MLA_ROPE // 2
    xf = x.astype(jnp.float32)
    y = jnp.concatenate([_rotate(xf[..., :half], ang_row), _rotate(xf[..., half:], ang_col)], axis=-1)
    return y.astype(x.dtype)


def _gated_delta_chunked(q, k, v, g, beta, s0):
    out_dtype = v.dtype
    bsz, nh, length, _ = q.shape
    dv = v.shape[-1]
    n = length // DELTA_CHUNK
    f32 = jnp.float32
    cs = lambda t: t.astype(f32).reshape(bsz, nh, n, DELTA_CHUNK, t.shape[-1])
    q, k, v = cs(q), cs(k), cs(v)
    g = g.astype(f32).reshape(bsz, nh, n, DELTA_CHUNK)
    beta = beta.astype(f32).reshape(bsz, nh, n, DELTA_CHUNK)
    gam = jnp.cumsum(g, axis=-1)
    idx = jnp.arange(DELTA_CHUNK)
    incl = idx[:, None] >= idx[None, :]
    strict = idx[:, None] > idx[None, :]
    decay = jnp.exp(jnp.where(incl, gam[..., :, None] - gam[..., None, :], -jnp.inf))
    kb = k * beta[..., None]
    m = jnp.where(strict, jnp.einsum('bhnid,bhnjd->bhnij', kb, k) * decay, 0.0)
    rhs = jnp.concatenate([v * beta[..., None], kb * jnp.exp(gam)[..., None]], axis=-1)
    sol = lax.linalg.triangular_solve(m + jnp.eye(DELTA_CHUNK, dtype=f32), rhs,
                                      left_side=True, lower=True, unit_diagonal=True)
    u_base, w = sol[..., :dv], sol[..., dv:]
    a_qk = jnp.einsum('bhnid,bhnjd->bhnij', q, k) * decay
    q_dec = q * jnp.exp(gam)[..., None]
    k_dec = k * jnp.exp(gam[..., -1:] - gam)[..., None]
    c_dec = jnp.exp(gam[..., -1])

    def step(s, xs):
        u_c, w_c, a_c, q_c, k_c, d_c = xs
        u = u_c - jnp.einsum('bhcd,bhdv->bhcv', w_c, s)
        o = jnp.einsum('bhcd,bhdv->bhcv', q_c, s) + jnp.einsum('bhij,bhjv->bhiv', a_c, u)
        s = d_c[..., None, None] * s + jnp.einsum('bhcd,bhcv->bhdv', k_c, u)
        return s, o

    xs = tuple(jnp.moveaxis(t, 2, 0) for t in (u_base, w, a_qk, q_dec, k_dec, c_dec))
    s_fin, o = lax.scan(step, s0.astype(f32), xs)
    o = jnp.moveaxis(o, 0, 2).reshape(bsz, nh, length, dv)
    return o.astype(out_dtype), s_fin


def _gla_chunked(q, k, v, log_a, s0):
    out_dtype = v.dtype
    bsz, nh, length, _ = q.shape
    dv = v.shape[-1]
    n = length // GLA_CHUNK
    f32 = jnp.float32
    cs = lambda t: t.astype(f32).reshape(bsz, nh, n, GLA_CHUNK, t.shape[-1])
    q, k, v, log_a = cs(q), cs(k), cs(v), cs(log_a)
    b = jnp.cumsum(log_a, axis=-2)
    idx = jnp.arange(GLA_CHUNK)
    incl = (idx[:, None] >= idx[None, :])[:, :, None]
    pair = jnp.exp(jnp.where(incl, b[..., :, None, :] - b[..., None, :, :], -jnp.inf))
    a_qk = jnp.einsum('bhnid,bhnjd,bhnijd->bhnij', q, k, pair)
    o_intra = jnp.einsum('bhnij,bhnjv->bhniv', a_qk, v)
    q_dec = q * jnp.exp(b)
    k_dec = k * jnp.exp(b[..., -1:, :] - b)
    c_dec = jnp.exp(b[..., -1, :])

    def step(s, xs):
        q_c, k_c, v_c, d_c = xs
        o = jnp.einsum('bhcd,bhdv->bhcv', q_c, s)
        s = d_c[..., None] * s + jnp.einsum('bhcd,bhcv->bhdv', k_c, v_c)
        return s, o

    xs = tuple(jnp.moveaxis(t, 2, 0) for t in (q_dec, k_dec, v, c_dec))
    s_fin, o_inter = lax.scan(step, s0.astype(f32), xs)
    o = o_intra + jnp.moveaxis(o_inter, 0, 2)
    return o.reshape(bsz, nh, length, dv).astype(out_dtype), s_fin


def _gdn_branch(pr, conv_w, a_log, dt_bias, norm_w, s0):
    bsz, length, _ = pr['gdn_q'].shape
    qkv = jnp.concatenate([pr['gdn_q'], pr['gdn_k'], pr['gdn_v']], axis=-1)
    qkv = jax.nn.silu(_centred_conv(qkv, conv_w))
    q, k, v = jnp.split(qkv, [GDN_H * GDN_DK, 2 * GDN_H * GDN_DK], axis=-1)
    q = _l2norm(_heads(q, GDN_H)) * (GDN_DK ** -0.5)
    k = _l2norm(_heads(k, GDN_H))
    v = _heads(v, GDN_H)
    f32 = jnp.float32
    beta = jax.nn.sigmoid(pr['gdn_b'].astype(f32)).reshape(bsz, length, 2, GDN_H).transpose(2, 0, 3, 1)
    a = pr['gdn_a'].astype(f32).reshape(bsz, length, 2, GDN_H).transpose(2, 0, 3, 1)
    g = -jnp.exp(a_log.astype(f32))[:, None, :, None] * jax.nn.softplus(
        a + dt_bias.astype(f32)[:, None, :, None])
    o_f, s_f = _gated_delta_chunked(q, k, v, g[0], beta[0], s0[:, 0])
    o_b, s_b = _gated_delta_chunked(_flip(q), _flip(k), _flip(v), _flip(g[1]), _flip(beta[1]), s0[:, 1])
    o = _rmsnorm(o_f + _flip(o_b), norm_w) * jax.nn.silu(_heads(pr['gdn_z'], GDN_H))
    return _merge_heads(o), jnp.stack([s_f, s_b], axis=1)


def _gla_branch(pr, gate_w2, gate_b, norm_w, s0):
    bsz, length, _ = pr['gla_q'].shape
    q = _heads(pr['gla_q'], GLA_H) * (GLA_DK ** -0.5)
    k = _heads(pr['gla_k'], GLA_H)
    v = _heads(pr['gla_v'], GLA_H)
    glr = pr['gla_g'].reshape(bsz, length, 2, GLA_RANK)
    logits = jnp.einsum('bltr,trk->tblk', glr, gate_w2) + gate_b[:, None, None, :]
    log_a = jax.nn.log_sigmoid(logits.astype(jnp.float32)) / GLA_TAU
    log_a = log_a.reshape(2, bsz, length, GLA_H, GLA_DK).transpose(0, 1, 3, 2, 4)
    o_f, s_f = _gla_chunked(q, k, v, log_a[0], s0[:, 0])
    o_b, s_b = _gla_chunked(_flip(q), _flip(k), _flip(v), _flip(log_a[1]), s0[:, 1])
    o = _rmsnorm(o_f + _flip(o_b), norm_w) * jax.nn.silu(_heads(pr['gla_r'], GLA_H))
    return _merge_heads(o), jnp.stack([s_f, s_b], axis=1)


def _hgrn_branch(pr, lb, norm_w, s0):
    bsz, length, _ = pr['hg_q'].shape
    q = jax.nn.silu(_heads(pr['hg_q'], HG_H))
    v = _heads(pr['hg_i'], HG_H)
    zf = pr['hg_f'].astype(jnp.float32).reshape(bsz, length, 2, HG_H * HG_DK).transpose(2, 0, 1, 3)
    lbb = lb[:, None, None, :]
    log_f = jnp.logaddexp(jnp.log(lbb), jnp.log1p(-lbb) + jax.nn.log_sigmoid(zf))
    one_minus_f = (1.0 - lbb) * jax.nn.sigmoid(-zf)
    to_h = lambda t: t.reshape(2, bsz, length, HG_H, HG_DK).transpose(0, 1, 3, 2, 4)
    log_f, one_minus_f = to_h(log_f), to_h(one_minus_f)
    o_f, s_f = _gla_chunked(q, one_minus_f[0], v, log_f[0], s0[:, 0])
    o_b, s_b = _gla_chunked(_flip(q), _flip(one_minus_f[1]), _flip(v), _flip(log_f[1]), s0[:, 1])
    o = _rmsnorm(o_f + _flip(o_b), norm_w) * jax.nn.sigmoid(_heads(pr['hg_g'], HG_H))
    return _merge_heads(o), jnp.stack([s_f, s_b], axis=1)


def _mla_project(pr, q_norm, wq_b, kv_norm, ang):
    q = _heads(_rmsnorm(pr['mla_qa'], q_norm) @ wq_b, MLA_H)
    q_nope, q_pe = q[..., :MLA_NOPE], q[..., MLA_NOPE:]
    ckv = _rmsnorm(pr['mla_kva'], kv_norm)
    kpe = pr['mla_kpe']
    if ang is not None:
        q_pe = _axial_rope(q_pe, ang[0], ang[1])
        kpe = _axial_rope(kpe, ang[0], ang[1])
    return q_nope, q_pe, ckv, kpe


def _mla_attend(q_nope, q_pe, k_nope, k_pe, v):
    bsz, nh, lq, _ = q_nope.shape
    nb = lq // ATTN_QBLOCK
    scale = (MLA_NOPE + MLA_ROPE) ** -0.5

    def blocks(t):
        return t.reshape(bsz, nh, nb, ATTN_QBLOCK, t.shape[-1]).transpose(2, 0, 1, 3, 4)

    def attend(qs):
        qn, qp = qs
        s = jnp.einsum('bhqd,bhkd->bhqk', qn, k_nope) + jnp.einsum('bhqd,bkd->bhqk', qp, k_pe)
        p = jax.nn.softmax(s.astype(jnp.float32) * scale, axis=-1)
        return jnp.einsum('bhqk,bhkd->bhqd', p.astype(v.dtype), v)

    o = lax.map(attend, (blocks(q_nope), blocks(q_pe)))
    return o.transpose(1, 2, 0, 3, 4).reshape(bsz, nh, lq, MLA_V)


def _layer(x, mod, P, l, lb, s_gdn0, s_gla0, s_hg0, ctx_ckv, ctx_kpe, ang, alpha):
    bsz, length, _ = x.shape
    shift1, scale1, gate1, shift2, scale2, gate2 = jnp.split(mod[:, None, :], 6, axis=-1)
    h = x * (1.0 + scale1) + shift1
    pr = _split_in(h @ P['w_in'][l])
    o_gdn, s_gdn = _gdn_branch(pr, P['gdn_conv'][l], P['gdn_a_log'][l], P['gdn_dt_bias'][l],
                               P['gdn_norm'][l], s_gdn0)
    o_gla, s_gla = _gla_branch(pr, P['gla_gate_w2'][l], P['gla_gate_b'][l], P['gla_norm'][l], s_gla0)
    o_hg, s_hg = _hgrn_branch(pr, lb, P['hgrn_norm'][l], s_hg0)
    q_nope, q_pe, ckv, kpe = _mla_project(pr, P['mla_q_norm'][l], P['mla_wq_b'][l],
                                          P['mla_kv_norm'][l], ang)
    if ctx_ckv is None:
        keys_ckv, keys_kpe = ckv, kpe
    else:
        keys_ckv = jnp.concatenate([ckv, ctx_ckv.astype(ckv.dtype)], axis=1)
        keys_kpe = jnp.concatenate([kpe, ctx_kpe.astype(kpe.dtype)], axis=1)
    kv = _heads(keys_ckv @ P['mla_wkv_b'][l], MLA_H)
    o_mla = _merge_heads(_mla_attend(q_nope, q_pe, kv[..., :MLA_NOPE], keys_kpe, kv[..., MLA_NOPE:]))
    branches = jnp.stack([o_gdn, o_gla, o_hg, o_mla], axis=0)
    proj = jnp.einsum('kbln,knd->kbld', branches, P['w_branch'][l])
    gates = jax.nn.sigmoid(pr['gates'].reshape(bsz, length, N_BRANCH, D_MODEL) + P['b_gates'][l])
    merged = jnp.einsum('blkd,kbld->bld', gates, proj)
    x = _layernorm(alpha * x + gate1 * (merged @ P['w_out'][l]), P['ln1_g'][l], P['ln1_b'][l])
    h2 = x * (1.0 + scale2) + shift2
    ff = (jax.nn.silu(h2 @ P['ffn_w1'][l]) * (h2 @ P['ffn_w3'][l])) @ P['ffn_w2'][l]
    x = _layernorm(alpha * x + gate2 * ff, P['ln2_g'][l], P['ln2_b'][l])
    return x, s_gdn, s_gla, s_hg, ckv, kpe


def setup_inputs(seed: int = 0) -> dict:
    key = jax.random.key(seed)
    ks = iter(jax.random.split(key, 40))

    def nrm(shape, scale):
        return jax.random.normal(next(ks), shape, jnp.float32) * scale

    def gain(shape):
        return 1.0 + nrm(shape, 0.1)

    res_scale = (8.0 * DEPTH) ** -0.25
    x_prompt = nrm((BATCH, SEQ, D_MODEL), 1.0)
    x_sample = nrm((DEC_BATCH, DEC_SEQ, D_MODEL), 1.0)
    c = nrm((DEC_BATCH, D_MODEL), 1.0)
    state_gdn = nrm((DEC_BATCH, DEPTH, 2, GDN_H, GDN_DK, GDN_DV), 0.1)
    state_gla = nrm((DEC_BATCH, DEPTH, 2, GLA_H, GLA_DK, GLA_DV), 0.5)
    state_hgrn = nrm((DEC_BATCH, DEPTH, 2, HG_H, HG_DK, HG_DV), 0.5)
    cache_mla_ckv = nrm((DEC_BATCH, DEPTH, PAST_LEN, KV_LORA), 1.0)
    cache_mla_kpe = nrm((DEC_BATCH, DEPTH, PAST_LEN, MLA_ROPE), 1.0)
    c_ctx = nrm((D_MODEL,), 1.0)
    w_ada = nrm((DEPTH, D_MODEL, 6 * D_MODEL), 0.5 * D_MODEL ** -0.5)
    b_ada = nrm((DEPTH, 6 * D_MODEL), 0.02)
    w_in = nrm((DEPTH, D_MODEL, IN_WIDTH), D_MODEL ** -0.5)
    gdn_conv = nrm((DEPTH, GDN_CONV, GDN_QKV), GDN_CONV ** -0.5)
    gdn_a_log = jnp.log(jax.random.uniform(next(ks), (DEPTH, 2, GDN_H), jnp.float32, 1.0, 16.0))
    dt = jnp.exp(jax.random.uniform(next(ks), (DEPTH, 2, GDN_H), jnp.float32,
                                    math.log(1e-3), math.log(1e-1)))
    gdn_dt_bias = dt + jnp.log(-jnp.expm1(-dt))
    gdn_norm = gain((DEPTH, GDN_DV))
    gla_gate_w2 = nrm((DEPTH, 2, GLA_RANK, GLA_H * GLA_DK), GLA_RANK ** -0.5)
    gla_gate_b = nrm((DEPTH, 2, GLA_H * GLA_DK), 0.1)
    gla_norm = gain((DEPTH, GLA_DV))
    hgrn_lb = nrm((DEPTH, 2, HG_H * HG_DK), 0.5)
    hgrn_norm = gain((DEPTH, HG_DV))
    mla_q_norm = gain((DEPTH, Q_LORA))
    mla_wq_b = nrm((DEPTH, Q_LORA, MLA_H * (MLA_NOPE + MLA_ROPE)), Q_LORA ** -0.5)
    mla_kv_norm = gain((DEPTH, KV_LORA))
    mla_wkv_b = nrm((DEPTH, KV_LORA, MLA_H * (MLA_NOPE + MLA_V)), KV_LORA ** -0.5)
    w_branch = nrm((DEPTH, N_BRANCH, BRANCH_W, D_MODEL), BRANCH_W ** -0.5 * res_scale)
    b_gates = nrm((DEPTH, N_BRANCH, D_MODEL), 0.02)
    w_out = nrm((DEPTH, D_MODEL, D_MODEL), D_MODEL ** -0.5 * res_scale)
    ln1_g = gain((DEPTH, D_MODEL))
    ln1_b = nrm((DEPTH, D_MODEL), 0.02)
    ln2_g = gain((DEPTH, D_MODEL))
    ln2_b = nrm((DEPTH, D_MODEL), 0.02)
    ffn_w1 = nrm((DEPTH, D_MODEL, D_FF), D_MODEL ** -0.5)
    ffn_w3 = nrm((DEPTH, D_MODEL, D_FF), D_MODEL ** -0.5)
    ffn_w2 = nrm((DEPTH, D_FF, D_MODEL), D_FF ** -0.5 * res_scale)
    return {
        'x_prompt': x_prompt, 'x_sample': x_sample, 'c': c,
        'state_gdn': state_gdn, 'state_gla': state_gla, 'state_hgrn': state_hgrn,
        'cache_mla_ckv': cache_mla_ckv, 'cache_mla_kpe': cache_mla_kpe,
        'c_ctx': c_ctx, 'w_ada': w_ada, 'b_ada': b_ada, 'w_in': w_in,
        'gdn_conv': gdn_conv, 'gdn_a_log': gdn_a_log, 'gdn_dt_bias': gdn_dt_bias, 'gdn_norm': gdn_norm,
        'gla_gate_w2': gla_gate_w2, 'gla_gate_b': gla_gate_b, 'gla_norm': gla_norm,
        'hgrn_lb': hgrn_lb, 'hgrn_norm': hgrn_norm,
        'mla_q_norm': mla_q_norm, 'mla_wq_b': mla_wq_b, 'mla_kv_norm': mla_kv_norm, 'mla_wkv_b': mla_wkv_b,
        'w_branch': w_branch, 'b_gates': b_gates, 'w_out': w_out,
        'ln1_g': ln1_g, 'ln1_b': ln1_b, 'ln2_g': ln2_g, 'ln2_b': ln2_b,
        'ffn_w1': ffn_w1, 'ffn_w3': ffn_w3, 'ffn_w2': ffn_w2,
    }


def reference(x_prompt, x_sample, c, state_gdn, state_gla, state_hgrn, cache_mla_ckv, cache_mla_kpe,
              c_ctx, w_ada, b_ada, w_in, gdn_conv, gdn_a_log, gdn_dt_bias, gdn_norm,
              gla_gate_w2, gla_gate_b, gla_norm, hgrn_lb, hgrn_norm,
              mla_q_norm, mla_wq_b, mla_kv_norm, mla_wkv_b, w_branch, b_gates, w_out,
              ln1_g, ln1_b, ln2_g, ln2_b, ffn_w1, ffn_w3, ffn_w2):
    P = {
        'w_in': w_in, 'gdn_conv': gdn_conv, 'gdn_a_log': gdn_a_log, 'gdn_dt_bias': gdn_dt_bias,
        'gdn_norm': gdn_norm, 'gla_gate_w2': gla_gate_w2, 'gla_gate_b': gla_gate_b, 'gla_norm': gla_norm,
        'hgrn_norm': hgrn_norm, 'mla_q_norm': mla_q_norm, 'mla_wq_b': mla_wq_b,
        'mla_kv_norm': mla_kv_norm, 'mla_wkv_b': mla_wkv_b, 'w_branch': w_branch, 'b_gates': b_gates,
        'w_out': w_out, 'ln1_g': ln1_g, 'ln1_b': ln1_b, 'ln2_g': ln2_g, 'ln2_b': ln2_b,
        'ffn_w1': ffn_w1, 'ffn_w3': ffn_w3, 'ffn_w2': ffn_w2,
    }
    alpha = (2.0 * DEPTH) ** 0.25
    cum = jnp.cumsum(jax.nn.softmax(hgrn_lb.astype(jnp.float32), axis=0), axis=0)
    lower_bounds = cum - cum[:1]

    bp = x_prompt.shape[0]
    f32 = jnp.float32
    zero_gdn = jnp.zeros((bp, 2, GDN_H, GDN_DK, GDN_DV), f32)
    zero_gla = jnp.zeros((bp, 2, GLA_H, GLA_DK, GLA_DV), f32)
    zero_hg = jnp.zeros((bp, 2, HG_H, HG_DK, HG_DV), f32)
    new_gdn, new_gla, new_hg, new_ckv, new_kpe = [], [], [], [], []
    y = x_prompt
    for l in range(DEPTH):
        mod = jax.nn.silu(c_ctx)[None, :] @ w_ada[l] + b_ada[l]
        y, s_g, s_l, s_h, ckv, kpe = _layer(y, mod, P, l, lower_bounds[l], zero_gdn, zero_gla, zero_hg,
                                            None, None, None, alpha)
        new_gdn.append(s_g)
        new_gla.append(s_l)
        new_hg.append(s_h)
        new_ckv.append(ckv)
        new_kpe.append(kpe)
    y_prompt = y
    sdt = x_prompt.dtype
    state_gdn_new = jnp.stack(new_gdn, axis=1).astype(sdt)
    state_gla_new = jnp.stack(new_gla, axis=1).astype(sdt)
    state_hgrn_new = jnp.stack(new_hg, axis=1).astype(sdt)
    cache_mla_ckv_new = jnp.stack(new_ckv, axis=1)
    cache_mla_kpe_new = jnp.stack(new_kpe, axis=1)

    ang = _axial_angles(x_sample.shape[1])
    z = x_sample
    for l in range(DEPTH):
        mod = jax.nn.silu(c) @ w_ada[l] + b_ada[l]
        z = _layer(z, mod, P, l, lower_bounds[l], state_gdn[:, l], state_gla[:, l], state_hgrn[:, l],
                   cache_mla_ckv[:, l], cache_mla_kpe[:, l], ang, alpha)[0]
    y_sample = z
    return (y_prompt, y_sample, state_gdn_new, state_gla_new, state_hgrn_new, cache_mla_ckv_new, cache_mla_kpe_new)
```

```cpp
#include <hip/hip_runtime.h>
#include <hip/hip_cooperative_groups.h>
#include <cstdio>
#include <cstdint>
namespace cg = cooperative_groups;

typedef unsigned short u16;
using bf16x8 = __attribute__((ext_vector_type(8))) short;
using f32x16 = __attribute__((ext_vector_type(16))) float;
using u32x4 = __attribute__((ext_vector_type(4))) unsigned;
using f32x4 = __attribute__((ext_vector_type(4))) float;
#define DEV __device__ __forceinline__

constexpr int D = 2048, NTOK = 6144, NKEY = 7168, PW = 7280, INW = 15472, INWP = 15488, DFF = 5632;
constexpr float EPS = 1e-6f;
constexpr float ALPHA = 1.41421356237f;
constexpr int C_GDQ = 0, C_GDZ = 1536, C_GDB = 2048, C_GDA = 2056, C_GLQ = 2064, C_GLK = 2320, C_GLV = 2576,
              C_GLR = 3088, C_GLG = 3600, C_HGQ = 3632, C_HGF = 4144, C_HGI = 5168, C_HGG = 5680, C_MQA = 6192,
              C_MKV = 6704, C_MKP = 7216;
constexpr size_t O_Y = 0, O_SGDN = 12582912, O_SGLA = 16777216, O_SHG = 18874368, O_CKV = 23068672, O_KPE = 27262976;

constexpr size_t al(size_t x) { return (x + 255) & ~(size_t)255; }
constexpr size_t W_WINT = 0;
constexpr size_t W_WQT = W_WINT + al((size_t)2 * INWP * 2048 * 2);
constexpr size_t W_WKVT = W_WQT + al((size_t)2 * 768 * 512 * 2);
constexpr size_t W_WBRT = W_WKVT + al((size_t)2 * 1024 * 512 * 2);
constexpr size_t W_WOUTT = W_WBRT + al((size_t)2 * 2048 * 2048 * 2);
constexpr size_t W_W13T = W_WOUTT + al((size_t)2 * 2048 * 2048 * 2);
constexpr size_t W_W2T = W_W13T + al((size_t)2 * 11264 * 2048 * 2);
constexpr size_t W_MODP = W_W2T + al((size_t)2 * 2048 * 5632 * 2);
constexpr size_t W_MOD = W_MODP + al((size_t)16 * 2 * 3 * 12288 * 4);
constexpr size_t W_CNT = W_MOD + al((size_t)2 * 3 * 12288 * 4);
constexpr size_t W_XA = W_CNT + 256;
constexpr size_t W_P = W_XA + al((size_t)NTOK * 2048 * 2);
constexpr size_t W_ACT = W_P;
constexpr size_t W_V = W_P + al((size_t)NTOK * DFF * 2);
constexpr size_t W_X1 = W_V + al((size_t)NTOK * 2048 * 4);
constexpr size_t W_G = W_P + al((size_t)NTOK * PW * 4);
constexpr size_t W_OBUF = W_G + al((size_t)NTOK * 8192 * 2);
constexpr size_t W_SC = W_OBUF;
constexpr size_t W_PM = W_OBUF + al((size_t)6 * NTOK * 512 * 4);
constexpr size_t W_MERGED = W_PM;
constexpr size_t W_X2 = W_PM + al((size_t)33554432);
constexpr size_t W_GDQ = W_X2 + al((size_t)NTOK * 2048 * 4);
constexpr size_t W_GDK = W_GDQ + al((size_t)NTOK * 512 * 4);
constexpr size_t W_GDV = W_GDK + al((size_t)NTOK * 512 * 4);
constexpr size_t W_GDEG = W_GDV + al((size_t)NTOK * 512 * 4);
constexpr size_t W_GDBT = W_GDEG + al((size_t)2 * NTOK * 4 * 4);
constexpr size_t W_GLAA = W_GDBT + al((size_t)2 * NTOK * 4 * 4);
constexpr size_t W_HGA = W_GLAA + al((size_t)2 * NTOK * 256 * 4);
constexpr size_t W_HGK = W_HGA + al((size_t)2 * NTOK * 512 * 4);
constexpr size_t W_HGQ = W_HGK + al((size_t)2 * NTOK * 512 * 4);
constexpr size_t W_AQ = W_HGQ + al((size_t)NTOK * 512 * 4);
constexpr size_t W_KEYS = W_AQ + al((size_t)NTOK * 512 * 2);
constexpr size_t W_QM = W_KEYS + al((size_t)NKEY * 512 * 2);
constexpr size_t W_KM = W_QM + al((size_t)NTOK * 768 * 2);
constexpr size_t W_VT = W_KM + al((size_t)NKEY * 768 * 2);
constexpr size_t W_BR = W_VT + al((size_t)512 * NKEY * 2);
constexpr size_t W_END = W_BR + al((size_t)NTOK * 2048 * 2);
static_assert(W_X1 + (size_t)NTOK * 2048 * 4 <= W_G, "alias overflow");
static_assert((size_t)16777216 + 50331648 <= (size_t)6 * NTOK * 512 * 4, "scores alias overflow");

struct Params {
  const float* in[35];
  float* out;
  char* ws;
};
enum { I_XP = 0, I_XS, I_C, I_SGDN, I_SGLA, I_SHG, I_CCKV, I_CKPE, I_CCTX, I_WADA, I_BADA, I_WIN, I_GCONV, I_GALOG,
       I_GDT, I_GNORM, I_GLW2, I_GLB, I_GLNORM, I_HGLB, I_HGNORM, I_QNORM, I_WQB, I_KVNORM, I_WKVB, I_WBR, I_BG,
       I_WOUT, I_LN1G, I_LN1B, I_LN2G, I_LN2B, I_W1, I_W3, I_W2 };

DEV int opaque(int x) { asm volatile("" : "+v"(x)); return x; }
DEV u16 f2bf(float f) { unsigned u = __float_as_uint(f); u += 0x7fffu + ((u >> 16) & 1u); return (u16)(u >> 16); }
DEV float bf2f(u16 h) { return __uint_as_float(((unsigned)h) << 16); }
DEV float sigm(float x) { return 1.f / (1.f + expf(-x)); }
DEV float silu(float x) { return x * sigm(x); }
DEV float softplus(float x) { return x > 20.f ? x : log1pf(expf(x)); }
DEV int row_vidx(int row) { return row < 4096 ? 0 : 1 + ((row - 4096) >> 10); }
DEV float wave_sum(float v) { for (int o = 32; o > 0; o >>= 1) v += __shfl_xor(v, o); return v; }
DEV float wave_max(float v) { for (int o = 32; o > 0; o >>= 1) v = fmaxf(v, __shfl_xor(v, o)); return v; }
DEV float block_sum(float v, float* red) {
  v = wave_sum(v); __syncthreads();
  if ((threadIdx.x & 63) == 0) red[threadIdx.x >> 6] = v;
  __syncthreads();
  return red[0] + red[1] + red[2] + red[3];
}
DEV float half_sum(float v, float* red) {
  v = wave_sum(v); __syncthreads();
  if ((threadIdx.x & 63) == 0) red[threadIdx.x >> 6] = v;
  __syncthreads();
  int w = threadIdx.x >> 6;
  return red[w & ~1] + red[w | 1];
}
DEV float dpp_ror_add(float x, float y8) { return x + y8; }
DEV float row16_allsum(float x) {
  x += __builtin_bit_cast(float, __builtin_amdgcn_update_dpp(0, __builtin_bit_cast(int, x), 0x128, 0xf, 0xf, false));
  x += __builtin_bit_cast(float, __builtin_amdgcn_update_dpp(0, __builtin_bit_cast(int, x), 0x124, 0xf, 0xf, false));
  x += __builtin_bit_cast(float, __builtin_amdgcn_update_dpp(0, __builtin_bit_cast(int, x), 0x122, 0xf, 0xf, false));
  x += __builtin_bit_cast(float, __builtin_amdgcn_update_dpp(0, __builtin_bit_cast(int, x), 0x121, 0xf, 0xf, false));
  return x;
}

constexpr int LSTR = 72;
DEV void gemm_main(const u16* A, int lda, const u16* B, int ldb, int K, f32x16 (&acc)[2][2], u16* sA, u16* sB) {
  const int tid = opaque(threadIdx.x), lane = tid & 63, wave = tid >> 6, wm = wave >> 1, wn = wave & 1;
  const int lr = tid >> 3, lc = (tid & 7) * 8;
  const u16* ga = A + (size_t)lr * lda + lc;
  const u16* gb = B + (size_t)lr * ldb + lc;
  u32x4 ra[4], rb[4];
#pragma unroll
  for (int i = 0; i < 4; i++) {
    ra[i] = *(const u32x4*)(ga + (size_t)(i * 32) * lda);
    rb[i] = *(const u32x4*)(gb + (size_t)(i * 32) * ldb);
  }
  const int nk = K >> 6;
  const int aoff = (wm * 64 + (lane & 31)) * LSTR + (lane >> 5) * 8;
  const int boff = (wn * 64 + (lane & 31)) * LSTR + (lane >> 5) * 8;
  for (int kt = 0; kt < nk; kt++) {
    __syncthreads();
#pragma unroll
    for (int i = 0; i < 4; i++) {
      *(u32x4*)(sA + (lr + i * 32) * LSTR + lc) = ra[i];
      *(u32x4*)(sB + (lr + i * 32) * LSTR + lc) = rb[i];
    }
    __syncthreads();
    if (kt + 1 < nk) {
      const int k0 = (kt + 1) << 6;
#pragma unroll
      for (int i = 0; i < 4; i++) {
        ra[i] = *(const u32x4*)(ga + (size_t)(i * 32) * lda + k0);
        rb[i] = *(const u32x4*)(gb + (size_t)(i * 32) * ldb + k0);
      }
    }
#pragma unroll
    for (int kk = 0; kk < 4; kk++) {
      bf16x8 a0 = *(const bf16x8*)(sA + aoff + kk * 16);
      bf16x8 a1 = *(const bf16x8*)(sA + aoff + 32 * LSTR + kk * 16);
      bf16x8 b0 = *(const bf16x8*)(sB + boff + kk * 16);
      bf16x8 b1 = *(const bf16x8*)(sB + boff + 32 * LSTR + kk * 16);
      acc[0][0] = __builtin_amdgcn_mfma_f32_32x32x16_bf16(a0, b0, acc[0][0], 0, 0, 0);
      acc[0][1] = __builtin_amdgcn_mfma_f32_32x32x16_bf16(a0, b1, acc[0][1], 0, 0, 0);
      acc[1][0] = __builtin_amdgcn_mfma_f32_32x32x16_bf16(a1, b0, acc[1][0], 0, 0, 0);
      acc[1][1] = __builtin_amdgcn_mfma_f32_32x32x16_bf16(a1, b1, acc[1][1], 0, 0, 0);
    }
  }
}
DEV void zero_acc(f32x16 (&acc)[2][2]) {
#pragma unroll
  for (int i = 0; i < 2; i++)
#pragma unroll
    for (int j = 0; j < 2; j++)
#pragma unroll
      for (int r = 0; r < 16; r++) acc[i][j][r] = 0.f;
}
#define EPI_BEGIN                                                                         \
  const int tid_ = opaque(threadIdx.x); const int lane_ = tid_ & 63, wave_ = tid_ >> 6, wm_ = wave_ >> 1, wn_ = wave_ & 1; \
  _Pragma("unroll") for (int mi = 0; mi < 2; mi++) _Pragma("unroll") for (int ni = 0; ni < 2; ni++) \
  _Pragma("unroll") for (int r = 0; r < 16; r++) {                                        \
    const int row = m0 + wm_ * 64 + mi * 32 + (r & 3) + 8 * (r >> 2) + 4 * (lane_ >> 5);  \
    const int col = n0 + wn_ * 64 + ni * 32 + (lane_ & 31);                               \
    const float av = acc[mi][ni][r];
#define EPI_END }

template <int MAP>
DEV void transpose_job(const float* __restrict__ W, int K, int N, u16* Wt, float* sT) {
  const int tid = opaque(threadIdx.x);
  const int ktn = K >> 6, ntn = (N + 63) >> 6;
  for (int t = blockIdx.x; t < ktn * ntn; t += gridDim.x) {
    const int kt = t % ktn, nt = t / ktn;
    const int k0 = kt * 64, n0 = nt * 64;
    __syncthreads();
#pragma unroll 4
    for (int i = 0; i < 16; i++) {
      int k = i * 4 + (tid >> 6), n = tid & 63;
      float v = (n0 + n < N) ? W[(size_t)(k0 + k) * N + n0 + n] : 0.f;
      sT[k * 65 + n] = v;
    }
    __syncthreads();
#pragma unroll 4
    for (int i = 0; i < 8; i++) {
      int n = i * 8 + (tid >> 5), kp = tid & 31;
      float v0 = sT[(2 * kp) * 65 + n], v1 = sT[(2 * kp + 1) * 65 + n];
      int ng = n0 + n, rr;
      if (MAP == 0) rr = ng;
      else if (MAP == 1) rr = (ng >> 5) * 64 + (ng & 31);
      else if (MAP == 2) rr = (ng >> 5) * 64 + 32 + (ng & 31);
      else { int h = ng >> 8, c = ng & 255; rr = (c < 128) ? (h * 128 + c) : (512 + h * 128 + (c - 128)); }
      *(unsigned*)(Wt + (size_t)rr * K + k0 + 2 * kp) = (unsigned)f2bf(v0) | ((unsigned)f2bf(v1) << 16);
    }
  }
}

template <int DK, int CC>
DEV void rec_diag(const float* Ap, int lda, const float* Kp, int ldk, const float* Qp, int ldq, const float* Vp, int ldv,
                  float* Op, float qscale, int L, int dir, const float* S0, float* Sout, float* lds) {
  constexpr int R = DK / 16, CW = 16 * CC, T = 16;
  constexpr int NA = (T * DK / 4) / 256;
  constexpr int NVT = T * CW / 4;
  constexpr int NV = (NVT + 255) / 256;
  const int tid = opaque(threadIdx.x), rg = tid & 15, cgi = tid >> 4;
  float* sA = lds; float* sK = sA + T * DK; float* sQ = sK + T * DK; float* sV = sQ + T * DK;
  float S[R][CC];
#pragma unroll
  for (int r = 0; r < R; r++)
#pragma unroll
    for (int c = 0; c < CC; c++) S[r][c] = S0 ? S0[(size_t)(rg * R + r) * 128 + cgi * CC + c] : 0.f;
  f32x4 pa[NA], pk[NA], pq[NA], pv[NV];
  auto gload = [&](int ch) {
#pragma unroll
    for (int i = 0; i < NA; i++) {
      int f = tid + i * 256; int s = f / (DK / 4), c4 = f % (DK / 4);
      int t = ch * T + s; if (dir) t = L - 1 - t;
      pa[i] = *(const f32x4*)(Ap + (size_t)t * lda + c4 * 4);
      pk[i] = *(const f32x4*)(Kp + (size_t)t * ldk + c4 * 4);
      pq[i] = *(const f32x4*)(Qp + (size_t)t * ldq + c4 * 4);
    }
#pragma unroll
    for (int i = 0; i < NV; i++) {
      int f = tid + i * 256;
      if (f < NVT) {
        int s = f / (CW / 4), c4 = f % (CW / 4);
        int t = ch * T + s; if (dir) t = L - 1 - t;
        pv[i] = *(const f32x4*)(Vp + (size_t)t * ldv + c4 * 4);
      }
    }
  };
  const int nch = L / T;
  gload(0);
  for (int ch = 0; ch < nch; ch++) {
    __syncthreads();
#pragma unroll
    for (int i = 0; i < NA; i++) {
      int f = tid + i * 256;
      ((f32x4*)sA)[f] = pa[i]; ((f32x4*)sK)[f] = pk[i]; ((f32x4*)sQ)[f] = pq[i];
    }
#pragma unroll
    for (int i = 0; i < NV; i++) { int f = tid + i * 256; if (f < NVT) ((f32x4*)sV)[f] = pv[i]; }
    __syncthreads();
    if (ch + 1 < nch) gload(ch + 1);
#pragma unroll 2
    for (int s = 0; s < T; s++) {
      float ar[R], kr[R], qr[R], vc[CC], os[CC];
#pragma unroll
      for (int r4 = 0; r4 < R / 4; r4++) {
        f32x4 x = *(const f32x4*)(sA + s * DK + rg * R + r4 * 4);
        ar[r4 * 4] = x.x; ar[r4 * 4 + 1] = x.y; ar[r4 * 4 + 2] = x.z; ar[r4 * 4 + 3] = x.w;
        x = *(const f32x4*)(sK + s * DK + rg * R + r4 * 4);
        kr[r4 * 4] = x.x; kr[r4 * 4 + 1] = x.y; kr[r4 * 4 + 2] = x.z; kr[r4 * 4 + 3] = x.w;
        x = *(const f32x4*)(sQ + s * DK + rg * R + r4 * 4);
        qr[r4 * 4] = x.x; qr[r4 * 4 + 1] = x.y; qr[r4 * 4 + 2] = x.z; qr[r4 * 4 + 3] = x.w;
      }
#pragma unroll
      for (int c = 0; c < CC; c++) { vc[c] = sV[s * CW + cgi * CC + c]; os[c] = 0.f; }
#pragma unroll
      for (int r = 0; r < R; r++)
#pragma unroll
        for (int c = 0; c < CC; c++) {
          float kv = kr[r] * vc[c];
          S[r][c] = fmaf(ar[r], S[r][c], kv);
          os[c] = fmaf(qr[r], S[r][c], os[c]);
        }
#pragma unroll
      for (int c = 0; c < CC; c++) os[c] = row16_allsum(os[c]);
      if (rg == 0) {
        int t = ch * T + s; if (dir) t = L - 1 - t;
        float* op = Op + (size_t)t * 512 + cgi * CC;
#pragma unroll
        for (int c = 0; c < CC; c++) op[c] = os[c] * qscale;
      }
    }
  }
  if (Sout) {
#pragma unroll
    for (int r = 0; r < R; r++)
#pragma unroll
      for (int c = 0; c < CC; c++) Sout[(size_t)(rg * R + r) * 128 + cgi * CC + c] = S[r][c];
  }
}

template <int CC>
DEV void rec_gdn(const float* Kp, const float* Qp, const float* Vp, const float* Egp, const float* Btp,
                 float* Op, int L, int dir, const float* S0, float* Sout, float* lds) {
  constexpr int DK = 128, R = 8, CW = 16 * CC, T = 16;
  constexpr int NA = 2;
  constexpr int NVT = T * CW / 4;
  constexpr int NV = (NVT + 255) / 256;
  const int tid = opaque(threadIdx.x), rg = tid & 15, cgi = tid >> 4;
  float* sK = lds; float* sQ = sK + T * DK; float* sV = sQ + T * DK; float* sE = sV + T * CW; float* sB = sE + T;
  float S[R][CC];
#pragma unroll
  for (int r = 0; r < R; r++)
#pragma unroll
    for (int c = 0; c < CC; c++) S[r][c] = S0 ? S0[(size_t)(rg * R + r) * 128 + cgi * CC + c] : 0.f;
  f32x4 pk[NA], pq[NA], pv[NV];
  float pe = 0.f, pb = 0.f;
  auto gload = [&](int ch) {
#pragma unroll
    for (int i = 0; i < NA; i++) {
      int f = tid + i * 256; int s = f / (DK / 4), c4 = f % (DK / 4);
      int t = ch * T + s; if (dir) t = L - 1 - t;
      pk[i] = *(const f32x4*)(Kp + (size_t)t * 512 + c4 * 4);
      pq[i] = *(const f32x4*)(Qp + (size_t)t * 512 + c4 * 4);
    }
#pragma unroll
    for (int i = 0; i < NV; i++) {
      int f = tid + i * 256;
      if (f < NVT) {
        int s = f / (CW / 4), c4 = f % (CW / 4);
        int t = ch * T + s; if (dir) t = L - 1 - t;
        pv[i] = *(const f32x4*)(Vp + (size_t)t * 512 + c4 * 4);
      }
    }
    if (tid < T) {
      int t = ch * T + tid; if (dir) t = L - 1 - t;
      pe = Egp[(size_t)t * 4]; pb = Btp[(size_t)t * 4];
    }
  };
  const int nch = L / T;
  gload(0);
  for (int ch = 0; ch < nch; ch++) {
    __syncthreads();
#pragma unroll
    for (int i = 0; i < NA; i++) { int f = tid + i * 256; ((f32x4*)sK)[f] = pk[i]; ((f32x4*)sQ)[f] = pq[i]; }
#pragma unroll
    for (int i = 0; i < NV; i++) { int f = tid + i * 256; if (f < NVT) ((f32x4*)sV)[f] = pv[i]; }
    if (tid < T) { sE[tid] = pe; sB[tid] = pb; }
    __syncthreads();
    if (ch + 1 < nch) gload(ch + 1);
#pragma unroll 2
    for (int s = 0; s < T; s++) {
      float kr[R], qr[R], vc[CC], dd[CC], os[CC];
#pragma unroll
      for (int r4 = 0; r4 < 2; r4++) {
        f32x4 x = *(const f32x4*)(sK + s * DK + rg * R + r4 * 4);
        kr[r4 * 4] = x.x; kr[r4 * 4 + 1] = x.y; kr[r4 * 4 + 2] = x.z; kr[r4 * 4 + 3] = x.w;
        x = *(const f32x4*)(sQ + s * DK + rg * R + r4 * 4);
        qr[r4 * 4] = x.x; qr[r4 * 4 + 1] = x.y; qr[r4 * 4 + 2] = x.z; qr[r4 * 4 + 3] = x.w;
      }
      const float e = sE[s], b = sB[s];
#pragma unroll
      for (int c = 0; c < CC; c++) { vc[c] = sV[s * CW + cgi * CC + c]; dd[c] = 0.f; os[c] = 0.f; }
#pragma unroll
      for (int r = 0; r < R; r++)
#pragma unroll
        for (int c = 0; c < CC; c++) dd[c] = fmaf(kr[r], S[r][c], dd[c]);
#pragma unroll
      for (int c = 0; c < CC; c++) { dd[c] = row16_allsum(dd[c]); dd[c] = b * (vc[c] - e * dd[c]); }
#pragma unroll
      for (int r = 0; r < R; r++)
#pragma unroll
        for (int c = 0; c < CC; c++) {
          float kc = kr[r] * dd[c];
          S[r][c] = fmaf(e, S[r][c], kc);
          os[c] = fmaf(qr[r], S[r][c], os[c]);
        }
#pragma unroll
      for (int c = 0; c < CC; c++) os[c] = row16_allsum(os[c]);
      if (rg == 0) {
        int t = ch * T + s; if (dir) t = L - 1 - t;
        float* op = Op + (size_t)t * 512 + cgi * CC;
#pragma unroll
        for (int c = 0; c < CC; c++) op[c] = os[c];
      }
    }
  }
  if (Sout) {
#pragma unroll
    for (int r = 0; r < R; r++)
#pragma unroll
      for (int c = 0; c < CC; c++) Sout[(size_t)(rg * R + r) * 128 + cgi * CC + c] = S[r][c];
  }
}

__global__ void __launch_bounds__(256, 2) mega(Params p) {
  cg::grid_group grid = cg::this_grid();
  __shared__ __attribute__((aligned(16))) char smem[36864 + 64];
  __shared__ int s_item;
  float* red = (float*)(smem + 36864);
  u16* sA = (u16*)smem; u16* sB = sA + 128 * LSTR;
  float* sf = (float*)smem;
  const int tid0 = threadIdx.x;
  const int nb = gridDim.x, bid = blockIdx.x;
#define PHASE_TID const int tid = opaque(tid0); const int lane = tid & 63, wave = tid >> 6; (void)lane; (void)wave;
  char* ws = p.ws;
  u16* WINT = (u16*)(ws + W_WINT); u16* WQT = (u16*)(ws + W_WQT); u16* WKVT = (u16*)(ws + W_WKVT);
  u16* WBRT = (u16*)(ws + W_WBRT); u16* WOUTT = (u16*)(ws + W_WOUTT); u16* W13T = (u16*)(ws + W_W13T);
  u16* W2T = (u16*)(ws + W_W2T);
  float* MODP = (float*)(ws + W_MODP); float* MOD = (float*)(ws + W_MOD); int* CNT = (int*)(ws + W_CNT);
  u16* XA = (u16*)(ws + W_XA); float* P = (float*)(ws + W_P); u16* ACT = (u16*)(ws + W_ACT);
  float* V = (float*)(ws + W_V); float* X1 = (float*)(ws + W_X1); u16* G = (u16*)(ws + W_G);
  float* OBUF = (float*)(ws + W_OBUF); float* SC = (float*)(ws + W_SC); u16* PM = (u16*)(ws + W_PM);
  u16* MERGED = (u16*)(ws + W_MERGED); float* X2 = (float*)(ws + W_X2);
  float* GDQ = (float*)(ws + W_GDQ); float* GDK = (float*)(ws + W_GDK); float* GDV = (float*)(ws + W_GDV);
  float* GDEG = (float*)(ws + W_GDEG); float* GDBT = (float*)(ws + W_GDBT); float* GLAA = (float*)(ws + W_GLAA);
  float* HGA = (float*)(ws + W_HGA); float* HGK = (float*)(ws + W_HGK); float* HGQ = (float*)(ws + W_HGQ);
  u16* AQ = (u16*)(ws + W_AQ); u16* KEYS = (u16*)(ws + W_KEYS); u16* QM = (u16*)(ws + W_QM);
  u16* KM = (u16*)(ws + W_KM); u16* VT = (u16*)(ws + W_VT); u16* BR = (u16*)(ws + W_BR);

    { PHASE_TID
  for (int l = 0; l < 2; l++) {
    transpose_job<0>(p.in[I_WIN] + (size_t)l * 2048 * INW, 2048, INW, WINT + (size_t)l * INWP * 2048, sf);
    transpose_job<1>(p.in[I_W1] + (size_t)l * 2048 * DFF, 2048, DFF, W13T + (size_t)l * 11264 * 2048, sf);
    transpose_job<2>(p.in[I_W3] + (size_t)l * 2048 * DFF, 2048, DFF, W13T + (size_t)l * 11264 * 2048, sf);
    transpose_job<0>(p.in[I_W2] + (size_t)l * DFF * 2048, DFF, 2048, W2T + (size_t)l * 2048 * DFF, sf);
    transpose_job<0>(p.in[I_WBR] + (size_t)l * 2048 * 2048, 2048, 2048, WBRT + (size_t)l * 2048 * 2048, sf);
    transpose_job<0>(p.in[I_WOUT] + (size_t)l * 2048 * 2048, 2048, 2048, WOUTT + (size_t)l * 2048 * 2048, sf);
    transpose_job<0>(p.in[I_WQB] + (size_t)l * 512 * 768, 512, 768, WQT + (size_t)l * 768 * 512, sf);
    transpose_job<3>(p.in[I_WKVB] + (size_t)l * 512 * 1024, 512, 1024, WKVT + (size_t)l * 1024 * 512, sf);
  }
  for (int it = bid; it < 1536; it += nb) {
    const int ks = it & 15, nbk = (it >> 4) % 48, l = it / (16 * 48);
    __syncthreads();
    if (tid < 128) {
      float c0 = p.in[I_CCTX][ks * 128 + tid], c1 = p.in[I_C][ks * 128 + tid], c2 = p.in[I_C][2048 + ks * 128 + tid];
      sf[tid] = silu(c0); sf[128 + tid] = silu(c1); sf[256 + tid] = silu(c2);
    }
    __syncthreads();
    const int n = nbk * 256 + tid;
    const float* w = p.in[I_WADA] + ((size_t)l * 2048 + ks * 128) * 12288 + n;
    float a0 = 0.f, a1 = 0.f, a2 = 0.f;
#pragma unroll 8
    for (int k = 0; k < 128; k++) {
      float wv = w[(size_t)k * 12288];
      a0 = fmaf(sf[k], wv, a0); a1 = fmaf(sf[128 + k], wv, a1); a2 = fmaf(sf[256 + k], wv, a2);
    }
    float* mp = MODP + (size_t)ks * (2 * 3 * 12288) + (size_t)l * 3 * 12288 + n;
    mp[0] = a0; mp[12288] = a1; mp[2 * 12288] = a2;
  }
    }
  grid.sync();
    { PHASE_TID
  for (int i = bid * 256 + tid; i < 2 * 3 * 12288; i += nb * 256) {
    int l = i / (3 * 12288), n = i % 12288;
    float a = p.in[I_BADA][l * 12288 + n];
    for (int ks = 0; ks < 16; ks++) a += MODP[(size_t)ks * (2 * 3 * 12288) + i];
    MOD[i] = a;
  }
    }
  grid.sync();
    { PHASE_TID
  for (int i = bid * 256 + tid; i < NTOK * 512; i += nb * 256) {
    int row = i >> 9, c = (i & 511) * 4;
    const float* xp = row < 4096 ? p.in[I_XP] + (size_t)row * 2048 : p.in[I_XS] + (size_t)(row - 4096) * 2048;
    float4 x = *(const float4*)(xp + c);
    const float* md = MOD + (size_t)row_vidx(row) * 12288;
    float4 sh = *(const float4*)(md + c), sc = *(const float4*)(md + 2048 + c);
    uint2 o;
    o.x = (unsigned)f2bf(x.x * (1.f + sc.x) + sh.x) | ((unsigned)f2bf(x.y * (1.f + sc.y) + sh.y) << 16);
    o.y = (unsigned)f2bf(x.z * (1.f + sc.z) + sh.z) | ((unsigned)f2bf(x.w * (1.f + sc.w) + sh.w) << 16);
    *(uint2*)(XA + (size_t)row * 2048 + c) = o;
  }
    }
  grid.sync();

  for (int l = 0; l < 2; l++) {
    const float* modl = MOD + (size_t)l * 3 * 12288;
    { PHASE_TID
    {
      const u16* Bt = WINT + (size_t)l * INWP * 2048;
      const float* bg = p.in[I_BG] + (size_t)l * 8192;
      for (int t = bid; t < 48 * 121; t += nb) {
        const int m0 = (t % 48) * 128, n0 = (t / 48) * 128;
        f32x16 acc[2][2]; zero_acc(acc);
        gemm_main(XA + (size_t)m0 * 2048, 2048, Bt + (size_t)n0 * 2048, 2048, 2048, acc, sA, sB);
        EPI_BEGIN
          if (col < PW) P[(size_t)row * PW + col] = av;
          else if (col < INW) G[(size_t)row * 8192 + (col - PW)] = f2bf(sigm(av + bg[col - PW]));
        EPI_END
      }
    }
    }
    grid.sync();
    { PHASE_TID
    for (int r = bid; r < NKEY; r += nb) {
      if (r >= NTOK) {
        const int e = r - NTOK, b = e >> 9, j = e & 511;
        const int keyrow = 4096 + b * 1536 + 1024 + j;
        const float* ck = p.in[I_CCKV] + ((size_t)(b * 2 + l) * 512 + j) * 512;
        KEYS[(size_t)keyrow * 512 + tid] = f2bf(ck[tid]);
        KEYS[(size_t)keyrow * 512 + 256 + tid] = f2bf(ck[256 + tid]);
        const float* kp = p.in[I_CKPE] + ((size_t)(b * 2 + l) * 512 + j) * 64;
        { int h = tid >> 6, c = tid & 63; KM[(size_t)keyrow * 768 + h * 192 + 128 + c] = f2bf(kp[c]); }
        continue;
      }
      const int row = r;
      const bool isctx = row < 4096;
      const int seq = isctx ? (row >> 8) : 16 + ((row - 4096) >> 10);
      const int t = isctx ? (row & 255) : ((row - 4096) & 1023);
      const int L = isctx ? 256 : 1024;
      const int keyrow = isctx ? row : 4096 + (seq - 16) * 1536 + t;
      const float* Pr = P + (size_t)row * PW;
      {
        const float* cw = p.in[I_GCONV] + (size_t)l * 5 * 1536;
#pragma unroll
        for (int i = 0; i < 6; i++) {
          const int ch = i * 256 + tid;
          float a = 0.f;
#pragma unroll
          for (int j = 0; j < 5; j++) {
            int tt = t + j - 2;
            if (tt >= 0 && tt < L) a = fmaf(Pr[(ptrdiff_t)(j - 2) * PW + ch], cw[j * 1536 + ch], a);
          }
          a = silu(a);
          if (i < 4) {
            float ss = half_sum(a * a, red);
            float rn = rsqrtf(ss + EPS);
            if (i < 2) GDQ[(size_t)row * 512 + ch] = a * rn * 0.08838834764831845f;
            else GDK[(size_t)row * 512 + (ch - 512)] = a * rn;
          } else GDV[(size_t)row * 512 + (ch - 1024)] = a;
        }
        if (tid < 8) {
          const int dir = tid >> 2, h = tid & 3;
          float bb = sigm(Pr[C_GDB + tid]);
          float aa = Pr[C_GDA + tid];
          float g = -expf(p.in[I_GALOG][l * 8 + tid]) * softplus(aa + p.in[I_GDT][l * 8 + tid]);
          GDEG[((size_t)dir * NTOK + row) * 4 + h] = expf(g);
          GDBT[((size_t)dir * NTOK + row) * 4 + h] = bb;
        }
      }
      {
#pragma unroll
        for (int dir = 0; dir < 2; dir++) {
          const float* w2 = p.in[I_GLW2] + ((size_t)(l * 2 + dir) * 16) * 256;
          float lg = p.in[I_GLB][(l * 2 + dir) * 256 + tid];
#pragma unroll
          for (int rr = 0; rr < 16; rr++) lg = fmaf(Pr[C_GLG + dir * 16 + rr], w2[rr * 256 + tid], lg);
          float ls = fminf(lg, 0.f) - log1pf(expf(-fabsf(lg)));
          GLAA[((size_t)dir * NTOK + row) * 256 + tid] = expf(ls * (1.f / 16.f));
        }
      }
      {
#pragma unroll
        for (int dir = 0; dir < 2; dir++)
#pragma unroll
          for (int i = 0; i < 2; i++) {
            const int c = i * 256 + tid;
            float lb = 0.f;
            if (l == 1) lb = sigm(p.in[I_HGLB][(2 + dir) * 512 + c] - p.in[I_HGLB][dir * 512 + c]);
            float z = Pr[C_HGF + dir * 512 + c];
            float sg = sigm(z), sn = sigm(-z);
            HGA[((size_t)dir * NTOK + row) * 512 + c] = lb + (1.f - lb) * sg;
            HGK[((size_t)dir * NTOK + row) * 512 + c] = (1.f - lb) * sn;
          }
#pragma unroll
        for (int i = 0; i < 2; i++) { const int c = i * 256 + tid; HGQ[(size_t)row * 512 + c] = silu(Pr[C_HGQ + c]); }
      }
      {
        float q0 = Pr[C_MQA + tid], q1 = Pr[C_MQA + 256 + tid];
        float ss = block_sum(q0 * q0 + q1 * q1, red);
        float rn = rsqrtf(ss * (1.f / 512.f) + EPS);
        const float* qn = p.in[I_QNORM] + l * 512;
        AQ[(size_t)row * 512 + tid] = f2bf(q0 * rn * qn[tid]);
        AQ[(size_t)row * 512 + 256 + tid] = f2bf(q1 * rn * qn[256 + tid]);
        float k0 = Pr[C_MKV + tid], k1 = Pr[C_MKV + 256 + tid];
        ss = block_sum(k0 * k0 + k1 * k1, red);
        rn = rsqrtf(ss * (1.f / 512.f) + EPS);
        const float* kn = p.in[I_KVNORM] + l * 512;
        float c0 = k0 * rn * kn[tid], c1 = k1 * rn * kn[256 + tid];
        KEYS[(size_t)keyrow * 512 + tid] = f2bf(c0);
        KEYS[(size_t)keyrow * 512 + 256 + tid] = f2bf(c1);
        if (isctx) {
          float* oc = p.out + O_CKV + ((size_t)(seq * 2 + l) * 256 + t) * 512;
          oc[tid] = c0; oc[256 + tid] = c1;
        }
        {
          const int h = tid >> 6, c = tid & 63;
          float val;
          if (isctx) {
            val = Pr[C_MKP + c];
            if (h == 0) p.out[O_KPE + ((size_t)(seq * 2 + l) * 256 + t) * 64 + c] = val;
          } else {
            const int hf = c >> 5, i = c & 15, second = (c >> 4) & 1;
            float x1 = Pr[C_MKP + hf * 32 + i], x2 = Pr[C_MKP + hf * 32 + 16 + i];
            float pos = hf ? (float)(t & 63) : (float)(t >> 6);
            float ang = pos * expf(-(float)i * (9.210340371976184f / 16.f));
            float sn, cs; sincosf(ang, &sn, &cs);
            val = second ? (x1 * sn + x2 * cs) : (x1 * cs - x2 * sn);
          }
          KM[(size_t)keyrow * 768 + h * 192 + 128 + c] = f2bf(val);
        }
      }
    }
    }
    grid.sync();
    { PHASE_TID
    for (int t = bid; t < 288 + 224 + 224; t += nb) {
      f32x16 acc[2][2]; zero_acc(acc);
      if (t < 288) {
        const int m0 = (t % 48) * 128, n0 = (t / 48) * 128;
        gemm_main(AQ + (size_t)m0 * 512, 512, WQT + (size_t)l * 768 * 512 + (size_t)n0 * 512, 512, 512, acc, sA, sB);
        const bool dec = m0 >= 4096;
        const int lane_ = lane, wm_ = wave >> 1, wn_ = wave & 1;
#pragma unroll
        for (int mi = 0; mi < 2; mi++)
#pragma unroll
          for (int ni = 0; ni < 2; ni++) {
            const int colbase = n0 + wn_ * 64 + ni * 32;
            const int c0 = colbase % 192;
            const bool pe = dec && (c0 >= 128);
#pragma unroll
            for (int r = 0; r < 16; r++) {
              const int row = m0 + wm_ * 64 + mi * 32 + (r & 3) + 8 * (r >> 2) + 4 * (lane_ >> 5);
              const int col = colbase + (lane_ & 31);
              float av = acc[mi][ni][r];
              if (pe) {
                float other = __shfl_xor(av, 16);
                const int tt = (row - 4096) & 1023;
                const int i = lane_ & 15, second = (lane_ >> 4) & 1;
                float pos = (c0 >= 160) ? (float)(tt & 63) : (float)(tt >> 6);
                float ang = pos * expf(-(float)i * (9.210340371976184f / 16.f));
                float sn, cs; sincosf(ang, &sn, &cs);
                av = second ? (other * sn + av * cs) : (av * cs - other * sn);
              }
              QM[(size_t)row * 768 + col] = f2bf(av);
            }
          }
      } else if (t < 512) {
        const int tt = t - 288;
        const int m0 = (tt % 56) * 128, n0 = (tt / 56) * 128;
        gemm_main(KEYS + (size_t)m0 * 512, 512, WKVT + (size_t)l * 1024 * 512 + (size_t)n0 * 512, 512, 512, acc, sA, sB);
        EPI_BEGIN
          KM[(size_t)row * 768 + (col >> 7) * 192 + (col & 127)] = f2bf(av);
        EPI_END
      } else {
        const int tt = t - 512;
        const int m0 = (tt & 3) * 128, n0 = (tt >> 2) * 128;
        gemm_main(WKVT + (size_t)l * 1024 * 512 + (size_t)(512 + m0) * 512, 512, KEYS + (size_t)n0 * 512, 512, 512, acc, sA, sB);
        EPI_BEGIN
          VT[(size_t)row * NKEY + col] = f2bf(av);
        EPI_END
      }
    }
    }
    grid.sync();
    { PHASE_TID
    for (int t = bid; t < 256 + 768; t += nb) {
      f32x16 acc[2][2]; zero_acc(acc);
      int m0, n0; const u16 *Ap, *Bp; float* Cp; int ldc;
      if (t < 256) {
        const int sh = t >> 2, seq = sh >> 2, h = sh & 3;
        m0 = ((t >> 1) & 1) * 128; n0 = (t & 1) * 128;
        Ap = QM + (size_t)(seq * 256) * 768 + h * 192; Bp = KM + (size_t)(seq * 256) * 768 + h * 192;
        Cp = SC + (size_t)sh * 256 * 256; ldc = 256;
      } else {
        const int tt = t - 256, bh = tt / 96, rem = tt % 96, b = bh >> 2, h = bh & 3;
        m0 = (rem / 12) * 128; n0 = (rem % 12) * 128;
        Ap = QM + (size_t)(4096 + b * 1024) * 768 + h * 192; Bp = KM + (size_t)(4096 + b * 1536) * 768 + h * 192;
        Cp = SC + (size_t)4194304 + (size_t)bh * 1024 * 1536; ldc = 1536;
      }
      gemm_main(Ap + (size_t)m0 * 768, 768, Bp + (size_t)n0 * 768, 768, 192, acc, sA, sB);
      EPI_BEGIN
        Cp[(size_t)row * ldc + col] = av;
      EPI_END
    }
    }
    grid.sync();
    { PHASE_TID
    {
      const float scale = 0.07216878364870323f;
      const int gw = bid * 4 + wave, nw = nb * 4;
      for (int r = gw; r < 16384; r += nw) {
        float4 v = *(const float4*)(SC + (size_t)r * 256 + lane * 4);
        float m = wave_max(fmaxf(fmaxf(v.x, v.y), fmaxf(v.z, v.w)));
        v.x = __expf((v.x - m) * scale); v.y = __expf((v.y - m) * scale);
        v.z = __expf((v.z - m) * scale); v.w = __expf((v.w - m) * scale);
        float inv = 1.f / wave_sum(v.x + v.y + v.z + v.w);
        uint2 o;
        o.x = (unsigned)f2bf(v.x * inv) | ((unsigned)f2bf(v.y * inv) << 16);
        o.y = (unsigned)f2bf(v.z * inv) | ((unsigned)f2bf(v.w * inv) << 16);
        *(uint2*)(PM + (size_t)r * 256 + lane * 4) = o;
      }
      for (int r = gw; r < 8192; r += nw) {
        const float* sp = SC + (size_t)4194304 + (size_t)r * 1536;
        u16* pp = PM + (size_t)4194304 + (size_t)r * 1536;
        float4 v[6];
        float m = -3.0e38f;
#pragma unroll
        for (int j = 0; j < 6; j++) {
          v[j] = *(const float4*)(sp + j * 256 + lane * 4);
          m = fmaxf(m, fmaxf(fmaxf(v[j].x, v[j].y), fmaxf(v[j].z, v[j].w)));
        }
        m = wave_max(m);
        float s = 0.f;
#pragma unroll
        for (int j = 0; j < 6; j++) {
          v[j].x = __expf((v[j].x - m) * scale); v[j].y = __expf((v[j].y - m) * scale);
          v[j].z = __expf((v[j].z - m) * scale); v[j].w = __expf((v[j].w - m) * scale);
          s += v[j].x + v[j].y + v[j].z + v[j].w;
        }
        float inv = 1.f / wave_sum(s);
#pragma unroll
        for (int j = 0; j < 6; j++) {
          uint2 o;
          o.x = (unsigned)f2bf(v[j].x * inv) | ((unsigned)f2bf(v[j].y * inv) << 16);
          o.y = (unsigned)f2bf(v[j].z * inv) | ((unsigned)f2bf(v[j].w * inv) << 16);
          *(uint2*)(pp + j * 256 + lane * 4) = o;
        }
      }
    }
    }
    grid.sync();
    { PHASE_TID
    for (int t = bid; t < 128 + 64; t += nb) {
      f32x16 acc[2][2]; zero_acc(acc);
      int m0, K, rowbase, h; const u16 *Ap, *Bp;
      if (t < 128) {
        const int sh = t >> 1, seq = sh >> 2; h = sh & 3;
        m0 = (t & 1) * 128; K = 256; rowbase = seq * 256;
        Ap = PM + (size_t)sh * 256 * 256; Bp = VT + (size_t)(h * 128) * NKEY + seq * 256;
      } else {
        const int tt = t - 128, bh = tt >> 3, b = bh >> 2; h = bh & 3;
        m0 = (tt & 7) * 128; K = 1536; rowbase = 4096 + b * 1024;
        Ap = PM + (size_t)4194304 + (size_t)bh * 1024 * 1536; Bp = VT + (size_t)(h * 128) * NKEY + 4096 + b * 1536;
      }
      gemm_main(Ap + (size_t)m0 * K, K, Bp, NKEY, K, acc, sA, sB);
      const int n0 = 0;
      EPI_BEGIN
        BR[(size_t)(rowbase + row) * 2048 + 1536 + h * 128 + col] = f2bf(av);
      EPI_END
    }
    }
    { PHASE_TID
    for (;;) {
      __syncthreads();
      if (tid == 0) s_item = atomicAdd(&CNT[l], 1);
      __syncthreads();
      const int it = s_item;
      if (it >= 576) break;
      int br, seq, h, dir, cb, cc8;
      if (it < 192) { br = it >> 6; const int u = (it & 63) >> 2; cb = it & 3; seq = 16 + (u >> 3); h = (u >> 1) & 3; dir = u & 1; cc8 = 0; }
      else { const int j = it - 192; br = j >> 7; const int u = j & 127; cb = 0; seq = u >> 3; h = (u >> 1) & 3; dir = u & 1; cc8 = 1; }
      const int row0 = seq < 16 ? seq * 256 : 4096 + (seq - 16) * 1024;
      const int L = seq < 16 ? 256 : 1024;
      const int colbase = cb * 32;
      if (br == 0) {
        const float* S0 = nullptr; float* So = nullptr;
        if (seq >= 16) S0 = p.in[I_SGDN] + ((((size_t)(seq - 16) * 2 + l) * 2 + dir) * 4 + h) * 16384 + colbase;
        else So = p.out + O_SGDN + ((((size_t)seq * 2 + l) * 2 + dir) * 4 + h) * 16384;
        const float* Kp = GDK + (size_t)row0 * 512 + h * 128; const float* Qp = GDQ + (size_t)row0 * 512 + h * 128;
        const float* Vp = GDV + (size_t)row0 * 512 + h * 128 + colbase;
        const float* Eg = GDEG + ((size_t)dir * NTOK + row0) * 4 + h; const float* Bt = GDBT + ((size_t)dir * NTOK + row0) * 4 + h;
        float* Op = OBUF + ((size_t)(0 * 2 + dir) * NTOK + row0) * 512 + h * 128 + colbase;
        if (cc8) rec_gdn<8>(Kp, Qp, Vp, Eg, Bt, Op, L, dir, S0, So, sf);
        else rec_gdn<2>(Kp, Qp, Vp, Eg, Bt, Op, L, dir, S0, So, sf);
      } else if (br == 1) {
        const float* S0 = nullptr; float* So = nullptr;
        if (seq >= 16) S0 = p.in[I_SHG] + ((((size_t)(seq - 16) * 2 + l) * 2 + dir) * 4 + h) * 16384 + colbase;
        else So = p.out + O_SHG + ((((size_t)seq * 2 + l) * 2 + dir) * 4 + h) * 16384;
        const float* Ap = HGA + ((size_t)dir * NTOK + row0) * 512 + h * 128; const float* Kp = HGK + ((size_t)dir * NTOK + row0) * 512 + h * 128;
        const float* Qp = HGQ + (size_t)row0 * 512 + h * 128;
        const float* Vp = P + (size_t)row0 * PW + C_HGI + h * 128 + colbase;
        float* Op = OBUF + ((size_t)(2 * 2 + dir) * NTOK + row0) * 512 + h * 128 + colbase;
        if (cc8) rec_diag<128, 8>(Ap, 512, Kp, 512, Qp, 512, Vp, PW, Op, 1.f, L, dir, S0, So, sf);
        else rec_diag<128, 2>(Ap, 512, Kp, 512, Qp, 512, Vp, PW, Op, 1.f, L, dir, S0, So, sf);
      } else {
        const float* S0 = nullptr; float* So = nullptr;
        if (seq >= 16) S0 = p.in[I_SGLA] + ((((size_t)(seq - 16) * 2 + l) * 2 + dir) * 4 + h) * 8192 + colbase;
        else So = p.out + O_SGLA + ((((size_t)seq * 2 + l) * 2 + dir) * 4 + h) * 8192;
        const float* Ap = GLAA + ((size_t)dir * NTOK + row0) * 256 + h * 64;
        const float* Kp = P + (size_t)row0 * PW + C_GLK + h * 64; const float* Qp = P + (size_t)row0 * PW + C_GLQ + h * 64;
        const float* Vp = P + (size_t)row0 * PW + C_GLV + h * 128 + colbase;
        float* Op = OBUF + ((size_t)(1 * 2 + dir) * NTOK + row0) * 512 + h * 128 + colbase;
        if (cc8) rec_diag<64, 8>(Ap, 256, Kp, PW, Qp, PW, Vp, PW, Op, 0.125f, L, dir, S0, So, sf);
        else rec_diag<64, 2>(Ap, 256, Kp, PW, Qp, PW, Vp, PW, Op, 0.125f, L, dir, S0, So, sf);
      }
    }
    }
    grid.sync();
    { PHASE_TID
    for (int row = bid; row < NTOK; row += nb) {
      const float* Pr = P + (size_t)row * PW;
#pragma unroll
      for (int i = 0; i < 6; i++) {
        const int e = i * 256 + tid, br = e >> 9, he = e & 511, d = he & 127;
        float o = OBUF[((size_t)(br * 2 + 0) * NTOK + row) * 512 + he] + OBUF[((size_t)(br * 2 + 1) * NTOK + row) * 512 + he];
        float ss = half_sum(o * o, red);
        float rn = rsqrtf(ss * (1.f / 128.f) + EPS);
        float w, gt;
        if (br == 0) { w = p.in[I_GNORM][l * 128 + d]; gt = silu(Pr[C_GDZ + he]); }
        else if (br == 1) { w = p.in[I_GLNORM][l * 128 + d]; gt = silu(Pr[C_GLR + he]); }
        else { w = p.in[I_HGNORM][l * 128 + d]; gt = sigm(Pr[C_HGG + he]); }
        BR[(size_t)row * 2048 + e] = f2bf(o * rn * w * gt);
      }
    }
    }
    grid.sync();
    { PHASE_TID
    for (int t = bid; t < 48 * 16; t += nb) {
      const int m0 = (t % 48) * 128, n0 = (t / 48) * 128;
      f32x16 mg[2][2]; zero_acc(mg);
      const u16* Bt = WBRT + (size_t)l * 2048 * 2048;
#pragma unroll 1
      for (int k = 0; k < 4; k++) {
        f32x16 acc[2][2]; zero_acc(acc);
        gemm_main(BR + (size_t)m0 * 2048 + k * 512, 2048, Bt + (size_t)n0 * 2048 + k * 512, 2048, 512, acc, sA, sB);
        EPI_BEGIN
          mg[mi][ni][r] = fmaf(bf2f(G[(size_t)row * 8192 + k * 2048 + col]), av, mg[mi][ni][r]);
        EPI_END
      }
      {
        f32x16 (&acc)[2][2] = mg;
        EPI_BEGIN
          MERGED[(size_t)row * 2048 + col] = f2bf(av);
        EPI_END
      }
    }
    }
    grid.sync();
    { PHASE_TID
    for (int t = bid; t < 48 * 16; t += nb) {
      const int m0 = (t % 48) * 128, n0 = (t / 48) * 128;
      f32x16 acc[2][2]; zero_acc(acc);
      gemm_main(MERGED + (size_t)m0 * 2048, 2048, WOUTT + (size_t)l * 2048 * 2048 + (size_t)n0 * 2048, 2048, 2048, acc, sA, sB);
      const float* g1 = modl + (size_t)row_vidx(m0) * 12288 + 4096;
      EPI_BEGIN
        float xv;
        if (l == 0) xv = row < 4096 ? p.in[I_XP][(size_t)row * 2048 + col] : p.in[I_XS][(size_t)(row - 4096) * 2048 + col];
        else xv = X2[(size_t)row * 2048 + col];
        V[(size_t)row * 2048 + col] = ALPHA * xv + g1[col] * av;
      EPI_END
    }
    }
    grid.sync();
    { PHASE_TID
    for (int row = bid; row < NTOK; row += nb) {
      const float* vr = V + (size_t)row * 2048;
      float4 a = *(const float4*)(vr + tid * 4), b = *(const float4*)(vr + 1024 + tid * 4);
      float mu = block_sum(a.x + a.y + a.z + a.w + b.x + b.y + b.z + b.w, red) * (1.f / 2048.f);
      a.x -= mu; a.y -= mu; a.z -= mu; a.w -= mu; b.x -= mu; b.y -= mu; b.z -= mu; b.w -= mu;
      float var = block_sum(a.x * a.x + a.y * a.y + a.z * a.z + a.w * a.w + b.x * b.x + b.y * b.y + b.z * b.z + b.w * b.w, red) * (1.f / 2048.f);
      float rn = rsqrtf(var + EPS);
      const float* md = modl + (size_t)row_vidx(row) * 12288;
#pragma unroll
      for (int hh = 0; hh < 2; hh++) {
        const int c = hh * 1024 + tid * 4;
        float4 x = hh ? b : a;
        float4 gg = *(const float4*)(p.in[I_LN1G] + l * 2048 + c), bb = *(const float4*)(p.in[I_LN1B] + l * 2048 + c);
        x.x = x.x * rn * gg.x + bb.x; x.y = x.y * rn * gg.y + bb.y; x.z = x.z * rn * gg.z + bb.z; x.w = x.w * rn * gg.w + bb.w;
        *(float4*)(X1 + (size_t)row * 2048 + c) = x;
        float4 sh = *(const float4*)(md + 6144 + c), sc = *(const float4*)(md + 8192 + c);
        uint2 o;
        o.x = (unsigned)f2bf(x.x * (1.f + sc.x) + sh.x) | ((unsigned)f2bf(x.y * (1.f + sc.y) + sh.y) << 16);
        o.y = (unsigned)f2bf(x.z * (1.f + sc.z) + sh.z) | ((unsigned)f2bf(x.w * (1.f + sc.w) + sh.w) << 16);
        *(uint2*)(XA + (size_t)row * 2048 + c) = o;
      }
    }
    }
    grid.sync();
    { PHASE_TID
    for (int t = bid; t < 48 * 88; t += nb) {
      const int m0 = (t % 48) * 128, n0 = (t / 48) * 128;
      f32x16 acc[2][2]; zero_acc(acc);
      gemm_main(XA + (size_t)m0 * 2048, 2048, W13T + (size_t)l * 11264 * 2048 + (size_t)n0 * 2048, 2048, 2048, acc, sA, sB);
      const int wm_ = wave >> 1, wn_ = wave & 1;
      const int cbase = ((n0 + wn_ * 64) >> 1) + (lane & 31);
#pragma unroll
      for (int mi = 0; mi < 2; mi++)
#pragma unroll
        for (int r = 0; r < 16; r++) {
          const int row = m0 + wm_ * 64 + mi * 32 + (r & 3) + 8 * (r >> 2) + 4 * (lane >> 5);
          ACT[(size_t)row * DFF + cbase] = f2bf(silu(acc[mi][0][r]) * acc[mi][1][r]);
        }
    }
    }
    grid.sync();
    { PHASE_TID
    for (int t = bid; t < 48 * 16; t += nb) {
      const int m0 = (t % 48) * 128, n0 = (t / 48) * 128;
      f32x16 acc[2][2]; zero_acc(acc);
      gemm_main(ACT + (size_t)m0 * DFF, DFF, W2T + (size_t)l * 2048 * DFF + (size_t)n0 * DFF, DFF, DFF, acc, sA, sB);
      const float* g2 = modl + (size_t)row_vidx(m0) * 12288 + 10240;
      EPI_BEGIN
        V[(size_t)row * 2048 + col] = ALPHA * X1[(size_t)row * 2048 + col] + g2[col] * av;
      EPI_END
    }
    }
    grid.sync();
    { PHASE_TID
    for (int row = bid; row < NTOK; row += nb) {
      const float* vr = V + (size_t)row * 2048;
      float4 a = *(const float4*)(vr + tid * 4), b = *(const float4*)(vr + 1024 + tid * 4);
      float mu = block_sum(a.x + a.y + a.z + a.w + b.x + b.y + b.z + b.w, red) * (1.f / 2048.f);
      a.x -= mu; a.y -= mu; a.z -= mu; a.w -= mu; b.x -= mu; b.y -= mu; b.z -= mu; b.w -= mu;
      float var = block_sum(a.x * a.x + a.y * a.y + a.z * a.z + a.w * a.w + b.x * b.x + b.y * b.y + b.z * b.z + b.w * b.w, red) * (1.f / 2048.f);
      float rn = rsqrtf(var + EPS);
      float* xo = (l == 1) ? (p.out + O_Y) : X2;
      const float* md = MOD + (size_t)(3 + row_vidx(row)) * 12288;
#pragma unroll
      for (int hh = 0; hh < 2; hh++) {
        const int c = hh * 1024 + tid * 4;
        float4 x = hh ? b : a;
        float4 gg = *(const float4*)(p.in[I_LN2G] + l * 2048 + c), bb = *(const float4*)(p.in[I_LN2B] + l * 2048 + c);
        x.x = x.x * rn * gg.x + bb.x; x.y = x.y * rn * gg.y + bb.y; x.z = x.z * rn * gg.z + bb.z; x.w = x.w * rn * gg.w + bb.w;
        *(float4*)(xo + (size_t)row * 2048 + c) = x;
        if (l == 0) {
          float4 sh = *(const float4*)(md + c), sc = *(const float4*)(md + 2048 + c);
          uint2 o;
          o.x = (unsigned)f2bf(x.x * (1.f + sc.x) + sh.x) | ((unsigned)f2bf(x.y * (1.f + sc.y) + sh.y) << 16);
          o.y = (unsigned)f2bf(x.z * (1.f + sc.z) + sh.z) | ((unsigned)f2bf(x.w * (1.f + sc.w) + sh.w) << 16);
          *(uint2*)(XA + (size_t)row * 2048 + c) = o;
        }
      }
    }
    }
    if (l == 0) grid.sync();
  }
}

extern "C" void kernel_launch(void* const* d_in, const int* in_sizes, int n_in, void* d_out, int out_size, void* d_ws,
                              size_t ws_size, hipStream_t stream) {
  if (ws_size < W_END) { fprintf(stderr, "workspace too small: %zu < %zu\n", ws_size, (size_t)W_END); return; }
  static int grid_blocks = 0;
  if (!grid_blocks) {
    int dev = 0, cus = 0, per_cu = 0;
    hipGetDevice(&dev);
    hipDeviceGetAttribute(&cus, hipDeviceAttributeMultiprocessorCount, dev);
    hipOccupancyMaxActiveBlocksPerMultiprocessor(&per_cu, mega, 256, 0);
    if (per_cu > 2) per_cu = 2;
    if (per_cu < 1) per_cu = 1;
    grid_blocks = cus * per_cu;
  }
  Params p{};
  for (int i = 0; i < 35; i++) p.in[i] = (const float*)d_in[i];
  p.out = (float*)d_out;
  p.ws = (char*)d_ws;
  hipMemsetAsync((char*)d_ws + W_CNT, 0, 256, stream);
  void* args[] = {&p};
  hipError_t e = hipLaunchCooperativeKernel((void*)mega, dim3(grid_blocks), dim3(256), args, 0, stream);
  if (e != hipSuccess) fprintf(stderr, "cooperative launch failed: %s (grid %d)\n", hipGetErrorString(e), grid_blocks);
}
```

```cpp
#include <hip/hip_runtime.h>
#include <hip/hip_cooperative_groups.h>
#include <cstdio>
#include <cstdint>
namespace cg = cooperative_groups;

typedef unsigned short u16;
using bf16x8 = __attribute__((ext_vector_type(8))) short;
using f32x16 = __attribute__((ext_vector_type(16))) float;
using u32x4 = __attribute__((ext_vector_type(4))) unsigned;
using u32x2 = __attribute__((ext_vector_type(2))) unsigned;
using f32x4 = __attribute__((ext_vector_type(4))) float;
using f32x2 = __attribute__((ext_vector_type(2))) float;
#define DEV __device__ __forceinline__
#ifndef PROBE_ID
#define PROBE_ID 0
#endif
#define REP_BEGIN(id) for (int rep_ = 0; rep_ < ((PROBE_ID == (id)) ? 2 : 1); rep_++) {
#define REP_END }

namespace pg8 {
#define PG8_LAS __attribute__((address_space(3)))
typedef unsigned short bf16_t;
typedef short bf16x8 __attribute__((ext_vector_type(8)));
typedef float f32x4 __attribute__((ext_vector_type(4)));
typedef unsigned u32x4 __attribute__((ext_vector_type(4)));
constexpr int BM = 256, BK = 64, HALF = 128, HTB = HALF * BK * 2  , STAGE_BYTES = 8 * HTB, NXCD = 8, WGM = 8;

__host__ __device__ __forceinline__ int lds_byte(int r, int c) { const int st = (r >> 4) * 2 + (c >> 5), rr = r & 15, cc = c & 31, ob = rr * 64 + cc * 2; return st * 1024 + (ob ^ (((ob >> 9) & 1) << 5)); }
__host__ __device__ __forceinline__ void stage_rc(int b, int& R, int& C) { const int st = b / 1024, sb = b % 1024, swz = sb ^ (((sb >> 9) & 1) << 5); R = (st >> 1) * 16 + swz / 64; C = (st & 1) * 32 + (swz % 64) / 2; }
__host__ __device__ __forceinline__ int perm32(int rho) { const int n = rho >> 4, i = rho & 15; return 8 * (i >> 2) + 4 * n + (i & 3); }

struct Unit { int pm, pn; };
struct Gemm { const bf16_t* A; const bf16_t* Bt; int M, N, K; int lda, ldb; };

struct StaticOrder {
    int nM, nN, nwg, G, c;
    __host__ __device__ void init(int M, int N, int G_, int c_) { nM = M / BM; nN = N / BM; nwg = nM * nN; G = G_; c = c_; }
    __host__ __device__ bool next(int i, Unit& u) const {
        const long L = (long)i * G + c; if (L >= nwg) return false;
        int wgid = (int)L; { const int q = nwg / NXCD, r = nwg % NXCD, xcd = wgid % NXCD, off = wgid / NXCD; wgid = (xcd < r ? xcd * (q + 1) : r * (q + 1) + (xcd - r) * q) + off; }
        const int nig = WGM * nN, gid = wgid / nig, fm = gid * WGM, gsz = (nM - fm) < WGM ? (nM - fm) : WGM;
        u.pm = fm + ((wgid % nig) % gsz); u.pn = (wgid % nig) / gsz; return true;
    }
    __device__ __forceinline__ void a_ready(const Unit&) const {}
    __device__ __forceinline__ void done(const Unit&) const {}
};
template <class Epi, class Sched, bool STAMP = false>
__device__ __forceinline__ void gemm_phase(PG8_LAS unsigned char* lds, const Gemm g, const Sched& S, const Epi& E, unsigned long long* stamps) {
    int tid = threadIdx.x; asm volatile("" : "+v"(tid)); const int wid = __builtin_amdgcn_readfirstlane(tid >> 6), lane = tid & 63, wr = wid >> 2, wc = wid & 3, fr = lane & 15, fq = lane >> 4;
    const int K = g.K, nt = K / BK;
    int ts_lo = 0, ts_hi = 0, nts = 0; const unsigned long long rt_entry = STAMP ? (unsigned long long)wall_clock64() : 0ull;
#define PG8_STAMP() do { if (STAMP && wid == 0 && nts < 64) { const unsigned long long _c = (unsigned long long)clock64(); \
        ts_lo = (lane == nts) ? (int)(unsigned)_c : ts_lo; ts_hi = (lane == nts) ? (int)(unsigned)(_c >> 32) : ts_hi; ++nts; } } while (0)
    PG8_STAMP();
    unsigned voffA[2], voffB[2];
#pragma unroll
    for (int i = 0; i < 2; ++i) { int R, C; stage_rc(tid * 16 + i * 8192, R, C); const int Rb = Epi::PERM ? ((R & ~31) + perm32(R & 31)) : R;
        voffA[i] = (unsigned)(R * g.lda + C) * 2u; voffB[i] = (unsigned)(Rb * g.ldb + C) * 2u; }
    const size_t kstep = (size_t)(BK * 2);
    const size_t hstepA = (size_t)HALF * g.lda * 2, hstepB = (size_t)HALF * g.ldb * 2;
    const size_t tstepA = 2 * hstepA, tstepB = 2 * hstepB;
    const unsigned ldsw = (unsigned)wid * 1024u;
    const int aoff = lds_byte(wr * 64 + fr, fq * 8), boff = lds_byte(wc * 32 + fr, fq * 8);
#define PG8_SA(b, h) (((b) * 2 + (h)) * HTB)
#define PG8_SB(b, h) ((4 + (b) * 2 + (h)) * HTB)
#define PG8_STAGE(bufoff, gbase, voff) do { _Pragma("unroll") for (int _i = 0; _i < 2; ++_i) \
        __builtin_amdgcn_global_load_lds((const unsigned*)((const char*)(gbase) + (voff)[_i]), (PG8_LAS unsigned*)(lds + (bufoff) + ldsw + _i * 8192), 16, 0, 0); } while (0)
#define PG8_LDA(dst, b, h) do { _Pragma("unroll") for (int m = 0; m < 4; ++m) _Pragma("unroll") for (int k = 0; k < 2; ++k) dst[m][k] = *(const PG8_LAS bf16x8*)(lds + PG8_SA(b, h) + aoff + m * 2048 + k * 1024); } while (0)
#define PG8_LDB(dst, b, h) do { _Pragma("unroll") for (int n = 0; n < 2; ++n) _Pragma("unroll") for (int k = 0; k < 2; ++k) dst[n][k] = *(const PG8_LAS bf16x8*)(lds + PG8_SB(b, h) + boff + n * 2048 + k * 1024); } while (0)
#define PG8_MMA(ai, bj, At, Bt) do { __builtin_amdgcn_s_setprio(1); _Pragma("unroll") for (int m = 0; m < 4; ++m) _Pragma("unroll") for (int n = 0; n < 2; ++n) _Pragma("unroll") for (int k = 0; k < 2; ++k) \
        acc[ai][bj][m][n] = __builtin_amdgcn_mfma_f32_16x16x32_bf16(Bt[n][k], At[m][k], acc[ai][bj][m][n], 0, 0, 0); __builtin_amdgcn_s_setprio(0); } while (0)
#define PG8_WAIT_V(n) asm volatile("s_waitcnt vmcnt(" #n ")" ::: "memory")
#define PG8_WAIT_L(n) asm volatile("s_waitcnt lgkmcnt(" #n ")" ::: "memory")
#define PG8_BAR __builtin_amdgcn_s_barrier()
#define PG8_SCHED __builtin_amdgcn_sched_barrier(0)
    Unit cur, nxt; int ui = 0;
    if (!S.next(0, cur)) return;
    f32x4 acc[2][2][4][2];
#pragma unroll
    for (int a = 0; a < 2; ++a)
#pragma unroll
        for (int b = 0; b < 2; ++b)
#pragma unroll
            for (int m = 0; m < 4; ++m)
#pragma unroll
                for (int n = 0; n < 2; ++n) acc[a][b][m][n] = (f32x4){0.f, 0.f, 0.f, 0.f};
    bf16x8 At[4][2], B0[2][2], B1[2][2];
    const char* cA = (const char*)g.A + (size_t)cur.pm * tstepA; const char* cB = (const char*)g.Bt + (size_t)cur.pn * tstepB;
    S.a_ready(cur);
    PG8_STAGE(PG8_SB(0, 0), cB, voffB); PG8_STAGE(PG8_SA(0, 0), cA, voffA); PG8_STAGE(PG8_SB(0, 1), cB + hstepB, voffB); PG8_STAGE(PG8_SA(0, 1), cA + hstepA, voffA);
    if (wr == 1) PG8_BAR;
    PG8_WAIT_V(4); PG8_BAR;
    PG8_STAGE(PG8_SB(1, 0), cB + kstep, voffB); PG8_STAGE(PG8_SA(1, 0), cA + kstep, voffA); PG8_STAGE(PG8_SB(1, 1), cB + hstepB + kstep, voffB);
    PG8_WAIT_V(6); PG8_BAR;
    PG8_STAMP();
    for (;;) {
        const bool has_next = S.next(ui + 1, nxt);
        const char* nA = has_next ? (const char*)g.A + (size_t)nxt.pm * tstepA : cA; const char* nB = has_next ? (const char*)g.Bt + (size_t)nxt.pn * tstepB : cB;
        for (int t = 0; t < nt; t += 2) {
            const bool last = (t == nt - 2);
            const char* a1 = cA + (size_t)(t + 1) * kstep;
            const char* a2 = last ? nA : cA + (size_t)(t + 2) * kstep; const char* b2 = last ? nB : cB + (size_t)(t + 2) * kstep;
            const char* a3 = a2 + kstep; const char* b3 = b2 + kstep;
            if (last && has_next) S.a_ready(nxt);
            PG8_LDB(B0, 0, 0); PG8_SCHED; PG8_LDA(At, 0, 0); PG8_STAGE(PG8_SA(1, 1), a1 + hstepA, voffA);
            PG8_WAIT_L(8); PG8_BAR; PG8_WAIT_L(0); PG8_MMA(0, 0, At, B0); PG8_BAR; PG8_SCHED;
            PG8_LDB(B1, 0, 1); PG8_STAGE(PG8_SB(0, 0), b2, voffB);
            PG8_BAR; PG8_WAIT_L(0); PG8_MMA(0, 1, At, B1); PG8_BAR;
            PG8_LDA(At, 0, 1); PG8_STAGE(PG8_SA(0, 0), a2, voffA);
            PG8_BAR; PG8_WAIT_L(0); PG8_MMA(1, 0, At, B0); PG8_BAR; PG8_SCHED;
            PG8_STAGE(PG8_SB(0, 1), b2 + hstepB, voffB);
            PG8_WAIT_V(6); PG8_BAR; PG8_MMA(1, 1, At, B1); PG8_BAR;
            PG8_LDB(B0, 1, 0); PG8_SCHED; PG8_LDA(At, 1, 0); PG8_STAGE(PG8_SA(0, 1), a2 + hstepA, voffA);
            PG8_WAIT_L(8); PG8_BAR; PG8_WAIT_L(0); PG8_MMA(0, 0, At, B0); PG8_BAR; PG8_SCHED;
            PG8_LDB(B1, 1, 1); PG8_STAGE(PG8_SB(1, 0), b3, voffB);
            PG8_BAR; PG8_WAIT_L(0); PG8_MMA(0, 1, At, B1); PG8_BAR;
            PG8_LDA(At, 1, 1); PG8_STAGE(PG8_SA(1, 0), a3, voffA);
            PG8_BAR; PG8_WAIT_L(0); PG8_MMA(1, 0, At, B0); PG8_BAR; PG8_SCHED;
            PG8_STAGE(PG8_SB(1, 1), b3 + hstepB, voffB);
            PG8_WAIT_V(6); PG8_BAR; PG8_MMA(1, 1, At, B1); PG8_BAR;
        }
        PG8_STAMP();
        if constexpr (!Epi::AFTER_DRAIN) { E(acc, cur, wr, wc, fr, fq); S.done(cur); }
        PG8_STAMP();
        if (!has_next) break;
        if constexpr (!Epi::KEEP) {
#pragma unroll
        for (int a = 0; a < 2; ++a)
#pragma unroll
            for (int b = 0; b < 2; ++b)
#pragma unroll
                for (int m = 0; m < 4; ++m)
#pragma unroll
                    for (int n = 0; n < 2; ++n) acc[a][b][m][n] = (f32x4){0.f, 0.f, 0.f, 0.f};
        }
        cur = nxt; cA = nA; cB = nB; ++ui;
    }
    PG8_WAIT_V(0);
    if (wr == 0) PG8_BAR;
    PG8_BAR;
    if constexpr (Epi::AFTER_DRAIN) { E.fused(acc, cur, wr, wc, fr, fq, lds, wid, lane); S.done(cur); }
    PG8_STAMP();
    if (STAMP && wid == 0) { stamps[lane] = lane < nts ? (((unsigned long long)(unsigned)ts_hi << 32) | (unsigned)ts_lo) : 0ull;
        if (lane == 62) stamps[62] = rt_entry; if (lane == 63) stamps[63] = (unsigned long long)wall_clock64(); }
#undef PG8_STAMP
#undef PG8_SA
#undef PG8_SB
#undef PG8_STAGE
#undef PG8_LDA
#undef PG8_LDB
#undef PG8_MMA
#undef PG8_WAIT_V
#undef PG8_WAIT_L
#undef PG8_BAR
#undef PG8_SCHED
}
}


#define XB_TMO      128
#define XB_XCNT(j)  (256  + 64 * (j))
#define XB_XSUB(j)  (1280 + 64 * (j))
#define XB_XGEN(j)  (2304 + 64 * (j))
#define XB_TOP      3328
#define XB_TOPGEN   3392
#define XCD_BAR_WORDS 3456
#define XB_SPIN_CAP (1u << 18)
#define LAS __attribute__((address_space(3)))

__device__ __forceinline__ unsigned xb_ld(unsigned* p)              { return __hip_atomic_load(p, __ATOMIC_RELAXED, __HIP_MEMORY_SCOPE_AGENT); }
__device__ __forceinline__ unsigned xb_add(unsigned* p, unsigned v) { return __hip_atomic_fetch_add(p, v, __ATOMIC_RELAXED, __HIP_MEMORY_SCOPE_AGENT); }
__device__ __forceinline__ unsigned xb_xcc_id() { return (unsigned)__builtin_amdgcn_s_getreg((3 << 11) | 20) & 0xFu; }
#define XB_SPIN(cond, bar) do { unsigned _sp = 0; while (cond) { __builtin_amdgcn_s_sleep(1); \
    if ((++_sp & 255u) == 0u) { if (xb_ld(&(bar)[XB_TMO])) break; if (_sp > XB_SPIN_CAP) { atomicAdd(&(bar)[XB_TMO], 1u); break; } } } } while (0)

struct XcdBarrier {
    unsigned* bar; unsigned x;
    volatile LAS unsigned* st;
};

__device__ __forceinline__ XcdBarrier xcd_barrier_post(unsigned* bar, volatile LAS unsigned* st) {
    XcdBarrier b; b.bar = bar; b.x = xb_xcc_id(); b.st = st;
    if (threadIdx.x == 0) (void)xb_add(&bar[XB_XCNT(b.x)], 1u);
    return b;
}
__device__ __forceinline__ void xcd_barrier_complete(unsigned* bar, unsigned x, unsigned& nloc, unsigned& nx) {
    const unsigned G = gridDim.x * gridDim.y * gridDim.z;
    unsigned sum, cnt, mine, sp = 0u;
    for (;;) {
        sum = 0u; cnt = 0u; mine = 0u;
#pragma unroll
        for (unsigned j = 0; j < 16; ++j) { const unsigned c = xb_ld(&bar[XB_XCNT(j)]); sum += c; cnt += (c > 0u) ? 1u : 0u; mine = (j == x) ? c : mine; }
        if (sum == G) break;
        __builtin_amdgcn_s_sleep(1);
        if ((++sp & 255u) == 0u) { if (xb_ld(&bar[XB_TMO])) break; if (sp > XB_SPIN_CAP) { atomicAdd(&bar[XB_TMO], 1u); break; } }
    }
    nloc = mine > 0u ? mine : 1u; nx = cnt > 0u ? cnt : 1u;
}

__device__ __forceinline__ void xcd_barrier(const XcdBarrier& b) {
    asm volatile("s_waitcnt vmcnt(0)" ::: "memory");
    __syncthreads();
    if (threadIdx.x == 0) {
        unsigned* bar = b.bar; const unsigned bx = xb_xcc_id();
        __builtin_amdgcn_s_waitcnt(0);
        unsigned nloc = b.st[0], nx = b.st[1];
        if (nloc == 0u) { xcd_barrier_complete(bar, bx, nloc, nx); b.st[0] = nloc; b.st[1] = nx; }
        const unsigned old = xb_add(&bar[XB_XSUB(bx)], 1u);
        const unsigned gen = old / nloc;
        if (old + 1u == (gen + 1u) * nloc) {
            __builtin_amdgcn_fence(__ATOMIC_RELEASE, "agent");
            asm volatile("s_waitcnt vmcnt(0)" ::: "memory");
            const unsigned og = xb_add(&bar[XB_TOP], 1u);
            const unsigned tg = og / nx;
            if (og + 1u == (tg + 1u) * nx) xb_add(&bar[XB_TOPGEN], 1u);
            else XB_SPIN(xb_ld(&bar[XB_TOPGEN]) == tg, bar);
            __builtin_amdgcn_fence(__ATOMIC_ACQUIRE, "agent");
            xb_add(&bar[XB_XGEN(bx)], 1u);
            asm volatile("s_waitcnt vmcnt(0)" ::: "memory");
        } else {
            XB_SPIN(xb_ld(&bar[XB_XGEN(bx)]) == gen, bar);
            __builtin_amdgcn_fence(__ATOMIC_ACQUIRE, "agent");
            asm volatile("s_waitcnt vmcnt(0)" ::: "memory");
        }
    }
    __syncthreads();
}

constexpr int D = 2048, NTOK = 6144, NKEY = 7168, PW = 7280, INW = 15472, INWP = 15616, DFF = 5632;
constexpr int NT = 512;
constexpr int LDK = 2048 + 64, LDF = 5632 + 64, LDB = 512 + 64;
constexpr int GS = 8192 + 128;
constexpr float EPS = 1e-6f;
constexpr float ALPHA = 1.41421356237f;
constexpr int C_GDQ = 0, C_GDZ = 1536, C_GDB = 2048, C_GDA = 2056, C_GLQ = 2064, C_GLK = 2320, C_GLV = 2576,
              C_GLR = 3088, C_GLG = 3600, C_HGQ = 3632, C_HGF = 4144, C_HGI = 5168, C_HGG = 5680, C_MQA = 6192,
              C_MKV = 6704, C_MKP = 7216;
constexpr size_t O_Y = 0, O_SGDN = 12582912, O_SGLA = 16777216, O_SHG = 18874368, O_CKV = 23068672, O_KPE = 27262976;

constexpr size_t al(size_t x) { return (x + 255) & ~(size_t)255; }
constexpr size_t W_WINT = 0;
constexpr size_t W_WQT = W_WINT + al((size_t)2 * INWP * LDK * 2);
constexpr size_t W_WKVT = W_WQT + al((size_t)2 * 768 * 512 * 2);
constexpr size_t W_WBRT = W_WKVT + al((size_t)2 * 1024 * 512 * 2);
constexpr size_t W_WOUTT = W_WBRT + al((size_t)2 * 4 * 2048 * LDB * 2);
constexpr size_t W_W13T = W_WOUTT + al((size_t)2 * 2048 * LDK * 2);
constexpr size_t W_W2T = W_W13T + al((size_t)2 * 11264 * LDK * 2);
constexpr size_t W_MODP = W_W2T + al((size_t)2 * 2048 * LDF * 2);
constexpr size_t W_MOD = W_MODP + al((size_t)16 * 2 * 3 * 12288 * 4);
constexpr size_t W_CNT = W_MOD + al((size_t)2 * 3 * 12288 * 4);
constexpr size_t W_BAR = W_CNT + 256;
constexpr size_t W_XA = W_BAR + al((size_t)XCD_BAR_WORDS * 4);
constexpr size_t W_P = W_XA + al((size_t)NTOK * LDK * 2);
constexpr size_t W_ACT = W_P;
constexpr size_t W_V = W_P + al((size_t)NTOK * LDF * 2);
constexpr size_t W_X1 = W_V + al((size_t)NTOK * 2048 * 4);
constexpr size_t W_G = W_P + al((size_t)NTOK * PW * 4);
constexpr size_t W_OBUF = W_G + al((size_t)NTOK * GS * 2);
constexpr size_t W_SC = W_OBUF;
constexpr size_t W_PM = W_OBUF + al((size_t)6 * NTOK * 512 * 4);
constexpr size_t W_MERGED = W_PM;
constexpr size_t W_X2 = W_PM + al((size_t)33554432);
constexpr size_t W_GDQ = W_X2 + al((size_t)NTOK * 2048 * 4);
constexpr size_t W_GDK = W_GDQ + al((size_t)NTOK * 512 * 4);
constexpr size_t W_GDV = W_GDK + al((size_t)NTOK * 512 * 4);
constexpr size_t W_GDEG = W_GDV + al((size_t)NTOK * 512 * 4);
constexpr size_t W_GDBT = W_GDEG + al((size_t)2 * NTOK * 4 * 4);
constexpr size_t W_GDKQ = W_GDBT + al((size_t)2 * NTOK * 4 * 4);
constexpr size_t W_GLAA = W_GDKQ + al((size_t)NTOK * 4 * 4);
constexpr size_t W_HGA = W_GLAA + al((size_t)2 * NTOK * 256 * 4);
constexpr size_t W_HGK = W_HGA + al((size_t)2 * NTOK * 512 * 4);
constexpr size_t W_HGQ = W_HGK + al((size_t)2 * NTOK * 512 * 4);
constexpr size_t W_AQ = W_HGQ + al((size_t)NTOK * 512 * 4);
constexpr size_t W_KEYS = W_AQ + al((size_t)NTOK * 512 * 2);
constexpr size_t W_QM = W_KEYS + al((size_t)NKEY * 512 * 2);
constexpr size_t W_KM = W_QM + al((size_t)NTOK * 768 * 2);
constexpr size_t W_VT = W_KM + al((size_t)NKEY * 768 * 2);
constexpr size_t W_BR = W_VT + al((size_t)512 * NKEY * 2);
constexpr size_t W_END = W_BR + al((size_t)4 * NTOK * LDB * 2);
static_assert(W_X1 + (size_t)NTOK * 2048 * 4 <= W_G, "alias overflow");
static_assert((size_t)16777216 + 50331648 <= (size_t)6 * NTOK * 512 * 4, "scores alias overflow");
constexpr size_t LDS_BYTES = 131072 + 256;

struct Params {
  const float* in[35];
  float* out;
  char* ws;
};
enum { I_XP = 0, I_XS, I_C, I_SGDN, I_SGLA, I_SHG, I_CCKV, I_CKPE, I_CCTX, I_WADA, I_BADA, I_WIN, I_GCONV, I_GALOG,
       I_GDT, I_GNORM, I_GLW2, I_GLB, I_GLNORM, I_HGLB, I_HGNORM, I_QNORM, I_WQB, I_KVNORM, I_WKVB, I_WBR, I_BG,
       I_WOUT, I_LN1G, I_LN1B, I_LN2G, I_LN2B, I_W1, I_W3, I_W2 };

DEV int opaque(int x) { asm volatile("" : "+v"(x)); return x; }
DEV u16 f2bf(float f) { unsigned u = __float_as_uint(f); u += 0x7fffu + ((u >> 16) & 1u); return (u16)(u >> 16); }
DEV unsigned pk2(float a, float b) { return (unsigned)f2bf(a) | ((unsigned)f2bf(b) << 16); }
DEV float bf2f(u16 h) { return __uint_as_float(((unsigned)h) << 16); }
DEV f32x4 ld4b(const u16* p) {
  const u32x2 v = *(const u32x2*)p; f32x4 r;
  r.x = __uint_as_float(v.x << 16); r.y = __uint_as_float(v.x & 0xffff0000u); r.z = __uint_as_float(v.y << 16); r.w = __uint_as_float(v.y & 0xffff0000u);
  return r;
}
DEV f32x2 ld2b(const u16* p) {
  const unsigned v = *(const unsigned*)p; f32x2 r;
  r.x = __uint_as_float(v << 16); r.y = __uint_as_float(v & 0xffff0000u);
  return r;
}
DEV float sigm(float x) { return __builtin_amdgcn_rcpf(1.f + __expf(-x)); }
DEV float silu(float x) { return x * sigm(x); }
DEV float fsigm(float x) { return __builtin_amdgcn_rcpf(1.f + __expf(-x)); }
DEV float softplus(float x) { return x > 20.f ? x : log1pf(expf(x)); }
DEV int row_vidx(int row) { return row < 4096 ? 0 : 1 + ((row - 4096) >> 10); }
template <int CTRL, int RMASK> DEV float dpp0(float x) {
  return __builtin_bit_cast(float, __builtin_amdgcn_update_dpp(0, __builtin_bit_cast(int, x), CTRL, RMASK, 0xf, false));
}
DEV float wave_sum(float v) {
  v += dpp0<0x128, 0xf>(v); v += dpp0<0x124, 0xf>(v); v += dpp0<0x122, 0xf>(v); v += dpp0<0x121, 0xf>(v);
  v += dpp0<0x142, 0xa>(v); v += dpp0<0x143, 0xc>(v);
  return __builtin_bit_cast(float, __builtin_amdgcn_readlane(__builtin_bit_cast(int, v), 63));
}
DEV float wave_max(float v) { for (int o = 32; o > 0; o >>= 1) v = fmaxf(v, __shfl_xor(v, o)); return v; }
DEV float q_sum(float v, float* red, int tid) {
  v = wave_sum(v); __syncthreads();
  if ((tid & 63) == 0) red[tid >> 6] = v;
  __syncthreads();
  const int w = (tid >> 6) & 4;
  return red[w] + red[w + 1] + red[w + 2] + red[w + 3];
}
DEV float block_sum(float v, float* red, int tid) {
  v = wave_sum(v); __syncthreads();
  if ((tid & 63) == 0) red[tid >> 6] = v;
  __syncthreads();
  return (red[0] + red[1]) + (red[2] + red[3]) + (red[4] + red[5]) + (red[6] + red[7]);
}
DEV float half_sum(float v, float* red, int tid) {
  v = wave_sum(v); __syncthreads();
  if ((tid & 63) == 0) red[tid >> 6] = v;
  __syncthreads();
  const int w = tid >> 6;
  return red[w & ~1] + red[w | 1];
}
DEV float row16_allsum(float x) {
  x += __builtin_bit_cast(float, __builtin_amdgcn_update_dpp(0, __builtin_bit_cast(int, x), 0x128, 0xf, 0xf, false));
  x += __builtin_bit_cast(float, __builtin_amdgcn_update_dpp(0, __builtin_bit_cast(int, x), 0x124, 0xf, 0xf, false));
  x += __builtin_bit_cast(float, __builtin_amdgcn_update_dpp(0, __builtin_bit_cast(int, x), 0x122, 0xf, 0xf, false));
  x += __builtin_bit_cast(float, __builtin_amdgcn_update_dpp(0, __builtin_bit_cast(int, x), 0x121, 0xf, 0xf, false));
  return x;
}

constexpr int LSTR = 72;
DEV void gemm_main(const u16* A, int lda, const u16* B, int ldb, int K, f32x16 (&acc)[2][2], u16* sA, u16* sB) {
  const int tid = opaque(threadIdx.x), lane = tid & 63, wave = tid >> 6, wm = wave >> 1, wn = wave & 1;
  const int lr = tid >> 3, lc = (tid & 7) * 8;
  const u16* ga = A + (size_t)lr * lda + lc;
  const u16* gb = B + (size_t)lr * ldb + lc;
  u32x4 ra[4], rb[2];
#pragma unroll
  for (int i = 0; i < 4; i++) ra[i] = *(const u32x4*)(ga + (size_t)(i * 64) * lda);
#pragma unroll
  for (int i = 0; i < 2; i++) rb[i] = *(const u32x4*)(gb + (size_t)(i * 64) * ldb);
  const int nk = K >> 6;
  const int aoff = (wm * 64 + (lane & 31)) * LSTR + (lane >> 5) * 8;
  const int boff = (wn * 64 + (lane & 31)) * LSTR + (lane >> 5) * 8;
  for (int kt = 0; kt < nk; kt++) {
    __syncthreads();
#pragma unroll
    for (int i = 0; i < 4; i++) *(u32x4*)(sA + (lr + i * 64) * LSTR + lc) = ra[i];
#pragma unroll
    for (int i = 0; i < 2; i++) *(u32x4*)(sB + (lr + i * 64) * LSTR + lc) = rb[i];
    __syncthreads();
    if (kt + 1 < nk) {
      const int k0 = (kt + 1) << 6;
#pragma unroll
      for (int i = 0; i < 4; i++) ra[i] = *(const u32x4*)(ga + (size_t)(i * 64) * lda + k0);
#pragma unroll
      for (int i = 0; i < 2; i++) rb[i] = *(const u32x4*)(gb + (size_t)(i * 64) * ldb + k0);
    }
#pragma unroll
    for (int kk = 0; kk < 4; kk++) {
      bf16x8 a0 = *(const bf16x8*)(sA + aoff + kk * 16);
      bf16x8 a1 = *(const bf16x8*)(sA + aoff + 32 * LSTR + kk * 16);
      bf16x8 b0 = *(const bf16x8*)(sB + boff + kk * 16);
      bf16x8 b1 = *(const bf16x8*)(sB + boff + 32 * LSTR + kk * 16);
      acc[0][0] = __builtin_amdgcn_mfma_f32_32x32x16_bf16(a0, b0, acc[0][0], 0, 0, 0);
      acc[0][1] = __builtin_amdgcn_mfma_f32_32x32x16_bf16(a0, b1, acc[0][1], 0, 0, 0);
      acc[1][0] = __builtin_amdgcn_mfma_f32_32x32x16_bf16(a1, b0, acc[1][0], 0, 0, 0);
      acc[1][1] = __builtin_amdgcn_mfma_f32_32x32x16_bf16(a1, b1, acc[1][1], 0, 0, 0);
    }
  }
}
DEV void zero_acc(f32x16 (&acc)[2][2]) {
#pragma unroll
  for (int i = 0; i < 2; i++)
#pragma unroll
    for (int j = 0; j < 2; j++)
#pragma unroll
      for (int r = 0; r < 16; r++) acc[i][j][r] = 0.f;
}
#define EPI_BEGIN                                                                         \
  const int tid_ = opaque(threadIdx.x); const int lane_ = tid_ & 63, wave_ = tid_ >> 6, wm_ = wave_ >> 1, wn_ = wave_ & 1; \
  _Pragma("unroll") for (int mi = 0; mi < 2; mi++) _Pragma("unroll") for (int ni = 0; ni < 2; ni++) \
  _Pragma("unroll") for (int r = 0; r < 16; r++) {                                        \
    const int row = m0 + wm_ * 64 + mi * 32 + (r & 3) + 8 * (r >> 2) + 4 * (lane_ >> 5);  \
    const int col = n0 + wn_ * 64 + ni * 32 + (lane_ & 31);                               \
    const float av = acc[mi][ni][r];
#define EPI_END }

struct EpiWin {
  static constexpr bool PERM = true, AFTER_DRAIN = false, KEEP = false;
  u16* P; u16* G; const float* bg;
  DEV void operator()(const f32x4 (&acc)[2][2][4][2], const pg8::Unit& u, int wr, int wc, int fr, int fq) const {
    const int pm = __builtin_amdgcn_readfirstlane(u.pm), pn = __builtin_amdgcn_readfirstlane(u.pn);
    const int row0 = pm * 256 + wr * 64 + fr, cu0 = pn * 256 + wc * 32;
#pragma unroll
    for (int bj = 0; bj < 2; ++bj) {
      const int col8 = cu0 + bj * 128 + 8 * fq;
      if (col8 < PW) {
        u16* pp = P + (size_t)row0 * PW + col8;
#pragma unroll
        for (int ai = 0; ai < 2; ++ai)
#pragma unroll
          for (int m = 0; m < 4; ++m) {
            const f32x4 v0 = acc[ai][bj][m][0], v1 = acc[ai][bj][m][1];
            u32x4 o; o.x = pk2(v0.x, v0.y); o.y = pk2(v0.z, v0.w); o.z = pk2(v1.x, v1.y); o.w = pk2(v1.z, v1.w);
            *(u32x4*)(pp + (size_t)(ai * 128 + m * 16) * PW) = o;
          }
      } else if (col8 < INW) {
        const int gc = col8 - PW;
        const f32x4 b0 = *(const f32x4*)(bg + gc), b1 = *(const f32x4*)(bg + gc + 4);
        u16* gp = G + (size_t)row0 * GS + gc;
#pragma unroll
        for (int ai = 0; ai < 2; ++ai)
#pragma unroll
          for (int m = 0; m < 4; ++m) {
            const f32x4 v0 = acc[ai][bj][m][0] + b0, v1 = acc[ai][bj][m][1] + b1;
            u32x4 o; o.x = pk2(fsigm(v0.x), fsigm(v0.y)); o.y = pk2(fsigm(v0.z), fsigm(v0.w)); o.z = pk2(fsigm(v1.x), fsigm(v1.y)); o.w = pk2(fsigm(v1.z), fsigm(v1.w));
            *(u32x4*)(gp + (size_t)(ai * 128 + m * 16) * GS) = o;
          }
      }
    }
  }
};
DEV f32x4 up4lo(u32x4 v) { f32x4 r; r.x = __uint_as_float(v.x << 16); r.y = __uint_as_float(v.x & 0xffff0000u); r.z = __uint_as_float(v.y << 16); r.w = __uint_as_float(v.y & 0xffff0000u); return r; }
DEV f32x4 up4hi(u32x4 v) { f32x4 r; r.x = __uint_as_float(v.z << 16); r.y = __uint_as_float(v.z & 0xffff0000u); r.z = __uint_as_float(v.w << 16); r.w = __uint_as_float(v.w & 0xffff0000u); return r; }
struct EpiRes {
  static constexpr bool PERM = true, AFTER_DRAIN = false, KEEP = false;
  u16* V; const u16* X; const float* gate;
  DEV void operator()(const f32x4 (&acc)[2][2][4][2], const pg8::Unit& u, int wr, int wc, int fr, int fq) const {
    const int pm = __builtin_amdgcn_readfirstlane(u.pm), pn = __builtin_amdgcn_readfirstlane(u.pn);
    const int row0 = pm * 256 + wr * 64 + fr, col0 = pn * 256 + wc * 32 + 8 * fq;
    const float* gp = gate + (size_t)row_vidx(pm * 256) * 12288 + col0;
    const u16* xp = X + (size_t)row0 * 2048 + col0;
    u16* vp = V + (size_t)row0 * 2048 + col0;
    f32x4 g[2][2];
#pragma unroll
    for (int bj = 0; bj < 2; ++bj)
#pragma unroll
      for (int n = 0; n < 2; ++n) g[bj][n] = *(const f32x4*)(gp + bj * 128 + n * 4);
#pragma unroll
    for (int ah = 0; ah < 4; ++ah) {
      const int ai = ah >> 1, mb = (ah & 1) * 2;
      u32x4 x[2][2];
#pragma unroll
      for (int mm = 0; mm < 2; ++mm)
#pragma unroll
        for (int bj = 0; bj < 2; ++bj) x[mm][bj] = *(const u32x4*)(xp + (size_t)(ai * 128 + (mb + mm) * 16) * 2048 + bj * 128);
#pragma unroll
      for (int mm = 0; mm < 2; ++mm)
#pragma unroll
        for (int bj = 0; bj < 2; ++bj) {
          const int m = mb + mm;
          const f32x4 v0 = up4lo(x[mm][bj]) * ALPHA + g[bj][0] * acc[ai][bj][m][0];
          const f32x4 v1 = up4hi(x[mm][bj]) * ALPHA + g[bj][1] * acc[ai][bj][m][1];
          u32x4 o; o.x = pk2(v0.x, v0.y); o.y = pk2(v0.z, v0.w); o.z = pk2(v1.x, v1.y); o.w = pk2(v1.z, v1.w);
          *(u32x4*)(vp + (size_t)(ai * 128 + m * 16) * 2048 + bj * 128) = o;
        }
    }
  }
};
struct EpiFfn1 {
  static constexpr bool PERM = true, AFTER_DRAIN = false, KEEP = false;
  u16* ACT;
  DEV void operator()(const f32x4 (&acc)[2][2][4][2], const pg8::Unit& u, int wr, int wc, int fr, int fq) const {
    const int pm = __builtin_amdgcn_readfirstlane(u.pm), pn = __builtin_amdgcn_readfirstlane(u.pn);
    const int row0 = pm * 256 + wr * 64 + fr, col0 = pn * 128 + wc * 32 + 8 * fq;
    u16* ap = ACT + (size_t)row0 * LDF + col0;
#pragma unroll
    for (int ai = 0; ai < 2; ++ai)
#pragma unroll
      for (int m = 0; m < 4; ++m) {
        const f32x4 a0 = acc[ai][0][m][0], a1 = acc[ai][0][m][1], b0 = acc[ai][1][m][0], b1 = acc[ai][1][m][1];
        u32x4 o;
        o.x = pk2(a0.x * fsigm(a0.x) * b0.x, a0.y * fsigm(a0.y) * b0.y);
        o.y = pk2(a0.z * fsigm(a0.z) * b0.z, a0.w * fsigm(a0.w) * b0.w);
        o.z = pk2(a1.x * fsigm(a1.x) * b1.x, a1.y * fsigm(a1.y) * b1.y);
        o.w = pk2(a1.z * fsigm(a1.z) * b1.z, a1.w * fsigm(a1.w) * b1.w);
        *(u32x4*)(ap + (size_t)(ai * 128 + m * 16) * LDF) = o;
      }
  }
};
struct BranchOrder {
  int c;
  DEV bool next(int i, pg8::Unit& u) const { if (c >= 192 || i >= 4) return false; u.pm = i * 24 + (c % 24); u.pn = i * 8 + (c / 24); return true; }
  DEV void a_ready(const pg8::Unit&) const {}
  DEV void done(const pg8::Unit&) const {}
};
struct EpiBranch {
  static constexpr bool PERM = true, AFTER_DRAIN = false, KEEP = true;
  u16* MERGED; const u16* G;
  DEV static f32x4 clampg(f32x4 g) { g.x = fmaxf(g.x, 1e-6f); g.y = fmaxf(g.y, 1e-6f); g.z = fmaxf(g.z, 1e-6f); g.w = fmaxf(g.w, 1e-6f); return g; }
  DEV static f32x4 ratio(f32x4 a, f32x4 b) { f32x4 r; r.x = a.x * __builtin_amdgcn_rcpf(b.x); r.y = a.y * __builtin_amdgcn_rcpf(b.y); r.z = a.z * __builtin_amdgcn_rcpf(b.z); r.w = a.w * __builtin_amdgcn_rcpf(b.w); return r; }
  DEV void operator()(f32x4 (&acc)[2][2][4][2], const pg8::Unit& u, int wr, int wc, int fr, int fq) const {
    const int upn = __builtin_amdgcn_readfirstlane(u.pn), upm = __builtin_amdgcn_readfirstlane(u.pm);
    const int k = upn >> 3, pn = upn & 7, pm = upm - k * 24;
    const int row0 = pm * 256 + wr * 64 + fr, col0 = pn * 256 + wc * 32 + 8 * fq;
    const u16* gbase = G + (size_t)row0 * GS + k * 2048 + col0;
    u16* obase = MERGED + (size_t)row0 * LDK + col0;
#pragma unroll
    for (int ah = 0; ah < 4; ++ah) {
      const int ai = ah >> 1, mb = (ah & 1) * 2;
      u32x4 r0[2][2], r1[2][2];
#pragma unroll
      for (int mm = 0; mm < 2; ++mm)
#pragma unroll
        for (int bj = 0; bj < 2; ++bj) {
          const u16* gp = gbase + (size_t)(ai * 128 + (mb + mm) * 16) * GS + bj * 128;
          r0[mm][bj] = *(const u32x4*)gp;
          if (k < 3) r1[mm][bj] = *(const u32x4*)(gp + 2048);
        }
#pragma unroll
      for (int mm = 0; mm < 2; ++mm)
#pragma unroll
        for (int bj = 0; bj < 2; ++bj) {
          const int m = mb + mm;
          const f32x4 g0l = clampg(up4lo(r0[mm][bj])), g0h = clampg(up4hi(r0[mm][bj]));
          if (k < 3) {
            const f32x4 g1l = clampg(up4lo(r1[mm][bj])), g1h = clampg(up4hi(r1[mm][bj]));
            acc[ai][bj][m][0] = acc[ai][bj][m][0] * ratio(g0l, g1l);
            acc[ai][bj][m][1] = acc[ai][bj][m][1] * ratio(g0h, g1h);
          } else {
            const f32x4 v0 = acc[ai][bj][m][0] * g0l, v1 = acc[ai][bj][m][1] * g0h;
            u32x4 o; o.x = pk2(v0.x, v0.y); o.y = pk2(v0.z, v0.w); o.z = pk2(v1.x, v1.y); o.w = pk2(v1.z, v1.w);
            *(u32x4*)(obase + (size_t)(ai * 128 + m * 16) * LDK + bj * 128) = o;
          }
        }
    }
  }
};

template <int MAP>
DEV void transpose_job(const float* __restrict__ W, int K, int N, u16* Wt, int ldt, float* sT, int tb, int tn, int t0 = 0, int t1 = 1 << 30) {
  const int tid = opaque(threadIdx.x);
  const int ktn = K >> 6, ntn = (N + 63) >> 6;
  const int tend = (ktn * ntn < t1) ? ktn * ntn : t1;
  for (int t = t0 + tb; t < tend; t += tn) {
    const int kt = t % ktn, nt = t / ktn;
    const int k0 = kt * 64, n0 = nt * 64;
    __syncthreads();
#pragma unroll
    for (int i = 0; i < 2; i++) {
      const int f = tid + i * NT, k = f >> 4, n4 = (f & 15) * 4;
      f32x4 v = {0.f, 0.f, 0.f, 0.f};
      if (n0 + n4 < N) v = *(const f32x4*)(W + (size_t)(k0 + k) * N + n0 + n4);
      sT[k * 65 + n4] = v.x; sT[k * 65 + n4 + 1] = v.y; sT[k * 65 + n4 + 2] = v.z; sT[k * 65 + n4 + 3] = v.w;
    }
    __syncthreads();
    {
      const int n = tid >> 3, kc = tid & 7;
      float v[8];
#pragma unroll
      for (int j = 0; j < 8; j++) v[j] = sT[(kc * 8 + j) * 65 + n];
      const int ng = n0 + n; int rr;
      if (MAP == 0) rr = ng;
      else if (MAP == 1) rr = (ng >> 7) * 256 + (ng & 127);
      else if (MAP == 2) rr = (ng >> 7) * 256 + 128 + (ng & 127);
      else { int h = ng >> 8, c = ng & 255; rr = (c < 128) ? (h * 128 + c) : (512 + h * 128 + (c - 128)); }
      u32x4 o; o.x = pk2(v[0], v[1]); o.y = pk2(v[2], v[3]); o.z = pk2(v[4], v[5]); o.w = pk2(v[6], v[7]);
      *(u32x4*)(Wt + (size_t)rr * ldt + k0 + kc * 8) = o;
    }
  }
}

template <int CTRL> DEV float dppmov(float x) { return __builtin_bit_cast(float, __builtin_amdgcn_mov_dpp(__builtin_bit_cast(int, x), CTRL, 0xf, 0xf, true)); }
template <int N> DEV void allsum_pairs(f32x2 (&v)[N]) {
#pragma unroll
  for (int i = 0; i < N; i++) { v[i].x += dppmov<0x128>(v[i].x); v[i].y += dppmov<0x128>(v[i].y); }
#pragma unroll
  for (int i = 0; i < N; i++) { v[i].x += dppmov<0x124>(v[i].x); v[i].y += dppmov<0x124>(v[i].y); }
#pragma unroll
  for (int i = 0; i < N; i++) { v[i].x += dppmov<0x122>(v[i].x); v[i].y += dppmov<0x122>(v[i].y); }
#pragma unroll
  for (int i = 0; i < N; i++) { v[i].x += dppmov<0x121>(v[i].x); v[i].y += dppmov<0x121>(v[i].y); }
}
template <int DK, int CC, bool HG = false>
DEV void rec_diag(const void* Apv, int lda, const u16* Kp, int ldk, const u16* Qp, int ldq, const u16* Vp, int ldv,
                  float* Op, float qscale, int L, int dir, const float* S0, float* Sout, float* lds, const float* lbp = nullptr) {
  constexpr int R = DK / 16, CW = 32 * CC, T = 16, NP = CC / 2;
  constexpr int NAT = T * DK / 4, NVT = T * CW / 4;
  const int tid = opaque(threadIdx.x), rg = tid & 15, cgi = tid >> 4;
  float* sA = lds; float* sK = sA + T * DK; float* sQ = sK + T * DK; float* sV = sQ + T * DK; float* sO = sV + T * CW;
  f32x2 S[R][NP];
#pragma unroll
  for (int r = 0; r < R; r++)
#pragma unroll
    for (int c = 0; c < NP; c++) {
      if (S0) S[r][c] = *(const f32x2*)(S0 + (size_t)(rg * R + r) * 128 + cgi * CC + 2 * c);
      else S[r][c] = (f32x2){0.f, 0.f};
    }
  f32x4 pa = {0, 0, 0, 0}, pk = {0, 0, 0, 0}, pq = {0, 0, 0, 0}, pv = {0, 0, 0, 0};
  const int sa_ = tid / (DK / 4), ca_ = (tid % (DK / 4)) * 4;
  const int sv_ = tid / (CW / 4), cv_ = (tid % (CW / 4)) * 4;
  const int nch = L / T;
  f32x4 lb4 = {0.f, 0.f, 0.f, 0.f};
  if (HG && lbp && tid < NAT) {
    const f32x4 l1 = *(const f32x4*)(lbp + 1024 + ca_), l0 = *(const f32x4*)(lbp + ca_);
    lb4.x = sigm(l1.x - l0.x); lb4.y = sigm(l1.y - l0.y); lb4.z = sigm(l1.z - l0.z); lb4.w = sigm(l1.w - l0.w);
  }
#define REC_LOAD(ch)                                                                              \
  {                                                                                               \
    if (tid < NAT) { int t = (ch) * T + sa_; if (dir) t = L - 1 - t;                              \
      if (HG) pa = ld4b((const u16*)Apv + (size_t)t * lda + ca_); else pa = *(const f32x4*)((const float*)Apv + (size_t)t * lda + ca_); \
      if (!HG) pk = ld4b(Kp + (size_t)t * ldk + ca_); \
      pq = ld4b(Qp + (size_t)t * ldq + ca_); }                                         \
    if (tid < NVT) { int t = (ch) * T + sv_; if (dir) t = L - 1 - t; pv = ld4b(Vp + (size_t)t * ldv + cv_); } \
  }
#define REC_FLUSH(ch)                                                                             \
  if (tid < NVT) { int t = (ch) * T + sv_; if (dir) t = L - 1 - t; *(f32x4*)(Op + (size_t)t * 512 + cv_) = ((const f32x4*)sO)[tid] * qscale; }
  REC_LOAD(0)
  for (int ch = 0; ch < nch; ch++) {
    __syncthreads();
    if (ch > 0) REC_FLUSH(ch - 1)
    if (HG) {
      if (tid < NAT) {
        f32x4 sg, sn, qq;
        sg.x = sigm(pa.x); sg.y = sigm(pa.y); sg.z = sigm(pa.z); sg.w = sigm(pa.w);
        sn.x = sigm(-pa.x); sn.y = sigm(-pa.y); sn.z = sigm(-pa.z); sn.w = sigm(-pa.w);
        qq.x = silu(pq.x); qq.y = silu(pq.y); qq.z = silu(pq.z); qq.w = silu(pq.w);
        const f32x4 oml = 1.f - lb4;
        ((f32x4*)sA)[tid] = lb4 + oml * sg; ((f32x4*)sK)[tid] = oml * sn; ((f32x4*)sQ)[tid] = qq;
      }
    } else
    if (tid < NAT) { ((f32x4*)sA)[tid] = pa; ((f32x4*)sK)[tid] = pk; ((f32x4*)sQ)[tid] = pq; }
    if (tid < NVT) ((f32x4*)sV)[tid] = pv;
    __syncthreads();
    if (ch + 1 < nch) REC_LOAD(ch + 1)
#pragma unroll 4
    for (int s = 0; s < T; s++) {
      float ar[R], kr[R], qr[R]; f32x2 vc[NP], os0[NP], os1[NP];
#pragma unroll
      for (int r4 = 0; r4 < R / 4; r4++) {
        f32x4 x = *(const f32x4*)(sA + s * DK + rg * R + r4 * 4);
        ar[r4 * 4] = x.x; ar[r4 * 4 + 1] = x.y; ar[r4 * 4 + 2] = x.z; ar[r4 * 4 + 3] = x.w;
        x = *(const f32x4*)(sK + s * DK + rg * R + r4 * 4);
        kr[r4 * 4] = x.x; kr[r4 * 4 + 1] = x.y; kr[r4 * 4 + 2] = x.z; kr[r4 * 4 + 3] = x.w;
        x = *(const f32x4*)(sQ + s * DK + rg * R + r4 * 4);
        qr[r4 * 4] = x.x; qr[r4 * 4 + 1] = x.y; qr[r4 * 4 + 2] = x.z; qr[r4 * 4 + 3] = x.w;
      }
#pragma unroll
      for (int c = 0; c < NP; c++) { vc[c] = *(const f32x2*)(sV + s * CW + cgi * CC + 2 * c); os0[c] = (f32x2){0.f, 0.f}; os1[c] = (f32x2){0.f, 0.f}; }
#pragma unroll
      for (int r = 0; r < R; r++)
#pragma unroll
        for (int c = 0; c < NP; c++) {
          f32x2 kv = vc[c] * kr[r];
          S[r][c] = __builtin_elementwise_fma((f32x2){ar[r], ar[r]}, S[r][c], kv);
          if (r & 1) os1[c] = __builtin_elementwise_fma((f32x2){qr[r], qr[r]}, S[r][c], os1[c]);
          else os0[c] = __builtin_elementwise_fma((f32x2){qr[r], qr[r]}, S[r][c], os0[c]);
        }
      f32x2 red[NP];
#pragma unroll
      for (int c = 0; c < NP; c++) red[c] = os0[c] + os1[c];
      allsum_pairs<NP>(red);
#pragma unroll
      for (int c = 0; c < NP; c++) *(f32x2*)(sO + s * CW + cgi * CC + 2 * c) = red[c];
    }
  }
  __syncthreads();
  REC_FLUSH(nch - 1)
#undef REC_LOAD
#undef REC_FLUSH
  if (Sout) {
#pragma unroll
    for (int r = 0; r < R; r++)
#pragma unroll
      for (int c = 0; c < NP; c++) *(f32x2*)(Sout + (size_t)(rg * R + r) * 128 + cgi * CC + 2 * c) = S[r][c];
  }
}

template <int CC>
DEV void rec_gdn(const float* Kp, const float* Qp, const float* Vp, const float* Egp, const float* Btp, const float* KQp,
                 float* Op, int L, int dir, const float* S0, float* Sout, float* lds) {
  constexpr int DK = 128, R = 8, CW = 32 * CC, T = 16, NP = CC / 2;
  constexpr int NVT = T * CW / 4;
  const int tid = opaque(threadIdx.x), rg = tid & 15, cgi = tid >> 4;
  float* sK = lds; float* sQ = sK + T * DK; float* sV = sQ + T * DK; float* sO = sV + T * CW; float* sE = sO + T * CW; float* sB = sE + T; float* sKQ = sB + T;
  f32x2 S[R][NP];
#pragma unroll
  for (int r = 0; r < R; r++)
#pragma unroll
    for (int c = 0; c < NP; c++) {
      if (S0) S[r][c] = *(const f32x2*)(S0 + (size_t)(rg * R + r) * 128 + cgi * CC + 2 * c);
      else S[r][c] = (f32x2){0.f, 0.f};
    }
  f32x4 pk = {0, 0, 0, 0}, pq = {0, 0, 0, 0}, pv = {0, 0, 0, 0};
  float pe = 0.f, pb = 0.f, pkq = 0.f;
  const int sa_ = tid >> 5, ca_ = (tid & 31) * 4;
  const int sv_ = tid / (CW / 4), cv_ = (tid % (CW / 4)) * 4;
  const int nch = L / T;
#define GDN_LOAD(ch)                                                                              \
  {                                                                                               \
    { int t = (ch) * T + sa_; if (dir) t = L - 1 - t;                                             \
      pk = *(const f32x4*)(Kp + (size_t)t * 512 + ca_); pq = *(const f32x4*)(Qp + (size_t)t * 512 + ca_); } \
    if (tid < NVT) { int t = (ch) * T + sv_; if (dir) t = L - 1 - t; pv = *(const f32x4*)(Vp + (size_t)t * 512 + cv_); } \
    if (tid < T) { int t = (ch) * T + tid; if (dir) t = L - 1 - t; pe = Egp[(size_t)t * 4]; pb = Btp[(size_t)t * 4]; pkq = KQp[(size_t)t * 4]; } \
  }
#define GDN_FLUSH(ch)                                                                             \
  if (tid < NVT) { int t = (ch) * T + sv_; if (dir) t = L - 1 - t; *(f32x4*)(Op + (size_t)t * 512 + cv_) = ((const f32x4*)sO)[tid]; }
  GDN_LOAD(0)
  for (int ch = 0; ch < nch; ch++) {
    __syncthreads();
    if (ch > 0) GDN_FLUSH(ch - 1)
    ((f32x4*)sK)[tid] = pk; ((f32x4*)sQ)[tid] = pq;
    if (tid < NVT) ((f32x4*)sV)[tid] = pv;
    if (tid < T) { sE[tid] = pe; sB[tid] = pb; sKQ[tid] = pkq; }
    __syncthreads();
    if (ch + 1 < nch) GDN_LOAD(ch + 1)
#pragma unroll 4
    for (int s = 0; s < T; s++) {
      float kr[R], qr[R]; f32x2 vc[NP], d0[NP], d1[NP], q0[NP], q1[NP];
#pragma unroll
      for (int r4 = 0; r4 < 2; r4++) {
        f32x4 x = *(const f32x4*)(sK + s * DK + rg * R + r4 * 4);
        kr[r4 * 4] = x.x; kr[r4 * 4 + 1] = x.y; kr[r4 * 4 + 2] = x.z; kr[r4 * 4 + 3] = x.w;
        x = *(const f32x4*)(sQ + s * DK + rg * R + r4 * 4);
        qr[r4 * 4] = x.x; qr[r4 * 4 + 1] = x.y; qr[r4 * 4 + 2] = x.z; qr[r4 * 4 + 3] = x.w;
      }
      const float e = sE[s], b = sB[s], kq = sKQ[s];
#pragma unroll
      for (int c = 0; c < NP; c++) {
        vc[c] = *(const f32x2*)(sV + s * CW + cgi * CC + 2 * c);
        d0[c] = (f32x2){0.f, 0.f}; d1[c] = (f32x2){0.f, 0.f}; q0[c] = (f32x2){0.f, 0.f}; q1[c] = (f32x2){0.f, 0.f};
      }
#pragma unroll
      for (int r = 0; r < R; r += 2)
#pragma unroll
        for (int c = 0; c < NP; c++) {
          d0[c] = __builtin_elementwise_fma((f32x2){kr[r], kr[r]}, S[r][c], d0[c]);
          q0[c] = __builtin_elementwise_fma((f32x2){qr[r], qr[r]}, S[r][c], q0[c]);
          d1[c] = __builtin_elementwise_fma((f32x2){kr[r + 1], kr[r + 1]}, S[r + 1][c], d1[c]);
          q1[c] = __builtin_elementwise_fma((f32x2){qr[r + 1], qr[r + 1]}, S[r + 1][c], q1[c]);
        }
      f32x2 red[2 * NP];
#pragma unroll
      for (int c = 0; c < NP; c++) { red[c] = d0[c] + d1[c]; red[NP + c] = q0[c] + q1[c]; }
      allsum_pairs<2 * NP>(red);
      f32x2 cc[NP];
#pragma unroll
      for (int c = 0; c < NP; c++) {
        cc[c] = (vc[c] - red[c] * e) * b;
        *(f32x2*)(sO + s * CW + cgi * CC + 2 * c) = red[NP + c] * e + cc[c] * kq;
      }
#pragma unroll
      for (int r = 0; r < R; r++)
#pragma unroll
        for (int c = 0; c < NP; c++) S[r][c] = __builtin_elementwise_fma((f32x2){e, e}, S[r][c], cc[c] * kr[r]);
    }
  }
  __syncthreads();
  GDN_FLUSH(nch - 1)
#undef GDN_LOAD
#undef GDN_FLUSH
  if (Sout) {
#pragma unroll
    for (int r = 0; r < R; r++)
#pragma unroll
      for (int c = 0; c < NP; c++) *(f32x2*)(Sout + (size_t)(rg * R + r) * 128 + cgi * CC + 2 * c) = S[r][c];
  }
}

DEV void rec_gdn8(const float* Kp, const float* Qp, const float* Vp, const float* Egp, const float* Btp, const float* KQp,
                  float* Op, int L, int dir, const float* S0, float* lds) {
  constexpr int DK = 128, R = 16, NPR = 8, CW = 64, T = 16;
  constexpr int NVT = T * CW / 4;
  const int tid = opaque(threadIdx.x), rg = tid & 7, cgi = tid >> 3;
  float* sK = lds; float* sQ = sK + T * DK; float* sV = sQ + T * DK; float* sO = sV + T * CW; float* sE = sO + T * CW; float* sB = sE + T; float* sKQ = sB + T;
  f32x2 S[NPR];
#pragma unroll
  for (int i = 0; i < NPR; i++) {
    S[i].x = S0[(size_t)(rg * R + 2 * i) * 128 + cgi];
    S[i].y = S0[(size_t)(rg * R + 2 * i + 1) * 128 + cgi];
  }
  f32x4 pk = {0, 0, 0, 0}, pq = {0, 0, 0, 0}, pv = {0, 0, 0, 0};
  float pe = 0.f, pb = 0.f, pkq = 0.f;
  const int sa_ = tid >> 5, ca_ = (tid & 31) * 4;
  const int sv_ = tid / (CW / 4), cv_ = (tid % (CW / 4)) * 4;
  const int nch = L / T;
#define GDN_LOAD(ch)                                                                              \
  {                                                                                               \
    { int t = (ch) * T + sa_; if (dir) t = L - 1 - t;                                             \
      pk = *(const f32x4*)(Kp + (size_t)t * 512 + ca_); pq = *(const f32x4*)(Qp + (size_t)t * 512 + ca_); } \
    if (tid < NVT) { int t = (ch) * T + sv_; if (dir) t = L - 1 - t; pv = *(const f32x4*)(Vp + (size_t)t * 512 + cv_); } \
    if (tid < T) { int t = (ch) * T + tid; if (dir) t = L - 1 - t; pe = Egp[(size_t)t * 4]; pb = Btp[(size_t)t * 4]; pkq = KQp[(size_t)t * 4]; } \
  }
#define GDN_FLUSH(ch)                                                                             \
  if (tid < NVT) { int t = (ch) * T + sv_; if (dir) t = L - 1 - t; *(f32x4*)(Op + (size_t)t * 512 + cv_) = ((const f32x4*)sO)[tid]; }
  GDN_LOAD(0)
  for (int ch = 0; ch < nch; ch++) {
    __syncthreads();
    if (ch > 0) GDN_FLUSH(ch - 1)
    ((f32x4*)sK)[tid] = pk; ((f32x4*)sQ)[tid] = pq;
    if (tid < NVT) ((f32x4*)sV)[tid] = pv;
    if (tid < T) { sE[tid] = pe; sB[tid] = pb; sKQ[tid] = pkq; }
    __syncthreads();
    if (ch + 1 < nch) GDN_LOAD(ch + 1)
#pragma unroll 4
    for (int s = 0; s < T; s++) {
      f32x2 k2[NPR], q2[NPR];
#pragma unroll
      for (int r4 = 0; r4 < 4; r4++) {
        f32x4 x = *(const f32x4*)(sK + s * DK + rg * R + r4 * 4);
        k2[2 * r4] = (f32x2){x.x, x.y}; k2[2 * r4 + 1] = (f32x2){x.z, x.w};
        x = *(const f32x4*)(sQ + s * DK + rg * R + r4 * 4);
        q2[2 * r4] = (f32x2){x.x, x.y}; q2[2 * r4 + 1] = (f32x2){x.z, x.w};
      }
      const float e = sE[s], b = sB[s], kq = sKQ[s], v = sV[s * CW + cgi];
      f32x2 d0 = k2[0] * S[0], d1 = k2[1] * S[1], g0 = q2[0] * S[0], g1 = q2[1] * S[1];
#pragma unroll
      for (int i = 2; i < NPR; i += 2) {
        d0 = __builtin_elementwise_fma(k2[i], S[i], d0); d1 = __builtin_elementwise_fma(k2[i + 1], S[i + 1], d1);
        g0 = __builtin_elementwise_fma(q2[i], S[i], g0); g1 = __builtin_elementwise_fma(q2[i + 1], S[i + 1], g1);
      }
      d0 = d0 + d1; g0 = g0 + g1;
      f32x2 red = {d0.x + d0.y, g0.x + g0.y};
      red.x += dppmov<0xB1>(red.x); red.y += dppmov<0xB1>(red.y);
      red.x += dppmov<0x4E>(red.x); red.y += dppmov<0x4E>(red.y);
      red.x += dppmov<0x141>(red.x); red.y += dppmov<0x141>(red.y);
      const float cc = b * (v - e * red.x);
      sO[s * CW + cgi] = e * red.y + kq * cc;
#pragma unroll
      for (int i = 0; i < NPR; i++) S[i] = __builtin_elementwise_fma((f32x2){e, e}, S[i], k2[i] * cc);
    }
  }
  __syncthreads();
  GDN_FLUSH(nch - 1)
#undef GDN_LOAD
#undef GDN_FLUSH
}

#define WINT ((u16*)(p.ws + W_WINT))
#define WQT ((u16*)(p.ws + W_WQT))
#define WKVT ((u16*)(p.ws + W_WKVT))
#define WBRT ((u16*)(p.ws + W_WBRT))
#define WOUTT ((u16*)(p.ws + W_WOUTT))
#define W13T ((u16*)(p.ws + W_W13T))
#define W2T ((u16*)(p.ws + W_W2T))
#define MODP ((float*)(p.ws + W_MODP))
#define MOD ((float*)(p.ws + W_MOD))
#define CNT ((int*)(p.ws + W_CNT))
#define XA ((u16*)(p.ws + W_XA))
#define P ((u16*)(p.ws + W_P))
#define ACT ((u16*)(p.ws + W_ACT))
#define V ((u16*)(p.ws + W_V))
#define X1 ((u16*)(p.ws + W_X1))
#define G ((u16*)(p.ws + W_G))
#define OBUF ((float*)(p.ws + W_OBUF))
#define SC ((float*)(p.ws + W_SC))
#define PM ((u16*)(p.ws + W_PM))
#define MERGED ((u16*)(p.ws + W_MERGED))
#define X2 ((u16*)(p.ws + W_X2))
#define GDQ ((float*)(p.ws + W_GDQ))
#define GDK ((float*)(p.ws + W_GDK))
#define GDV ((float*)(p.ws + W_GDV))
#define GDEG ((float*)(p.ws + W_GDEG))
#define GDBT ((float*)(p.ws + W_GDBT))
#define GDKQ ((float*)(p.ws + W_GDKQ))
#define GLAA ((float*)(p.ws + W_GLAA))
#define HGA ((float*)(p.ws + W_HGA))
#define HGK ((float*)(p.ws + W_HGK))
#define HGQ ((float*)(p.ws + W_HGQ))
#define AQ ((u16*)(p.ws + W_AQ))
#define KEYS ((u16*)(p.ws + W_KEYS))
#define QM ((u16*)(p.ws + W_QM))
#define KM ((u16*)(p.ws + W_KM))
#define VT ((u16*)(p.ws + W_VT))
#define BR ((u16*)(p.ws + W_BR))
__global__ void __launch_bounds__(512, 2) mega(Params p) {
  cg::grid_group grid = cg::this_grid();
  extern __shared__ __attribute__((aligned(16))) unsigned char smem[];
  float* red = (float*)(smem + 131072);
  int* s_item = (int*)(smem + 131072 + 128);
  u16* sA = (u16*)smem; u16* sB = sA + 256 * LSTR;
  float* sf = (float*)smem;
  const int tid0 = threadIdx.x;
  const int nb = gridDim.x, bid = blockIdx.x;
  if (tid0 < 4) ((volatile unsigned*)(smem + 131072 + 192))[tid0] = 0u;
  __syncthreads();
  const XcdBarrier xb = xcd_barrier_post((unsigned*)(p.ws + W_BAR), (volatile LAS unsigned*)(smem + 131072 + 192));
#define PHASE_TID const int tid = opaque(tid0); const int lane = tid & 63, wave = tid >> 6; (void)lane; (void)wave;
    REP_BEGIN(1)
  { PHASE_TID
  for (int l = 0; l < 2; l++) {
    const bool bg = (l == 1) && (nb > 192);
    transpose_job<0>(p.in[I_WIN] + (size_t)l * 2048 * INW, 2048, INW, WINT + (size_t)l * INWP * LDK, LDK, sf, bid, nb, bg ? 1920 : 0);
    if (l == 0 || nb <= 192) {
    transpose_job<1>(p.in[I_W1] + (size_t)l * 2048 * DFF, 2048, DFF, W13T + (size_t)l * 11264 * LDK, LDK, sf, bid, nb);
    transpose_job<2>(p.in[I_W3] + (size_t)l * 2048 * DFF, 2048, DFF, W13T + (size_t)l * 11264 * LDK, LDK, sf, bid, nb);
    transpose_job<0>(p.in[I_W2] + (size_t)l * DFF * 2048, DFF, 2048, W2T + (size_t)l * 2048 * LDF, LDF, sf, bid, nb);
    }
    if (!bg) {
    for (int k = 0; k < 4; k++)
      transpose_job<0>(p.in[I_WBR] + (size_t)(l * 4 + k) * 512 * 2048, 512, 2048, WBRT + (size_t)(l * 4 + k) * 2048 * LDB, LDB, sf, bid, nb);
    transpose_job<0>(p.in[I_WOUT] + (size_t)l * 2048 * 2048, 2048, 2048, WOUTT + (size_t)l * 2048 * LDK, LDK, sf, bid, nb);
    }
    transpose_job<0>(p.in[I_WQB] + (size_t)l * 512 * 768, 512, 768, WQT + (size_t)l * 768 * 512, 512, sf, bid, nb);
    transpose_job<3>(p.in[I_WKVB] + (size_t)l * 512 * 1024, 512, 1024, WKVT + (size_t)l * 1024 * 512, 512, sf, bid, nb);
  }
  for (int it = bid; it < 768; it += nb) {
    const int ks = it & 15, nbk = (it >> 4) % 24, l = it / (16 * 24);
    __syncthreads();
    if (tid < 128) {
      float c0 = p.in[I_CCTX][ks * 128 + tid], c1 = p.in[I_C][ks * 128 + tid], c2 = p.in[I_C][2048 + ks * 128 + tid];
      sf[tid] = silu(c0); sf[128 + tid] = silu(c1); sf[256 + tid] = silu(c2);
    }
    __syncthreads();
    const int n = nbk * 512 + tid;
    const float* w = p.in[I_WADA] + ((size_t)l * 2048 + ks * 128) * 12288 + n;
    float a0 = 0.f, a1 = 0.f, a2 = 0.f;
#pragma unroll 32
    for (int k = 0; k < 128; k++) {
      float wv = w[(size_t)k * 12288];
      a0 = fmaf(sf[k], wv, a0); a1 = fmaf(sf[128 + k], wv, a1); a2 = fmaf(sf[256 + k], wv, a2);
    }
    float* mp = MODP + (size_t)ks * (2 * 3 * 12288) + (size_t)l * 3 * 12288 + n;
    mp[0] = a0; mp[12288] = a1; mp[2 * 12288] = a2;
  }
  }
  grid.sync();
    REP_END
  { PHASE_TID
  for (int i = bid * NT + tid; i < 2 * 3 * 12288; i += nb * NT) {
    int l = i / (3 * 12288), n = i % 12288;
    float a = p.in[I_BADA][l * 12288 + n];
    for (int ks = 0; ks < 16; ks++) a += MODP[(size_t)ks * (2 * 3 * 12288) + i];
    MOD[i] = a;
  }
  }
  xcd_barrier(xb);
  { PHASE_TID
  for (int i = bid * NT + tid; i < NTOK * 512; i += nb * NT) {
    int row = i >> 9, c = (i & 511) * 4;
    const float* xp = row < 4096 ? p.in[I_XP] + (size_t)row * 2048 : p.in[I_XS] + (size_t)(row - 4096) * 2048;
    f32x4 x = *(const f32x4*)(xp + c);
    const float* md = MOD + (size_t)row_vidx(row) * 12288;
    f32x4 sh = *(const f32x4*)(md + c), sc = *(const f32x4*)(md + 2048 + c);
    u32x2 o;
    o.x = pk2(x.x * (1.f + sc.x) + sh.x, x.y * (1.f + sc.y) + sh.y);
    o.y = pk2(x.z * (1.f + sc.z) + sh.z, x.w * (1.f + sc.w) + sh.w);
    *(u32x2*)(XA + (size_t)row * LDK + c) = o;
    o.x = pk2(x.x, x.y); o.y = pk2(x.z, x.w);
    *(u32x2*)(X2 + (size_t)row * 2048 + c) = o;
  }
  }
  xcd_barrier(xb);

  for (int l = 0; l < 2; l++) {
    const float* modl = MOD + (size_t)l * 3 * 12288;
    REP_BEGIN(4)
    {
      pg8::Gemm g{XA, WINT + (size_t)l * INWP * LDK, NTOK, INWP, 2048, LDK, LDK};
      pg8::StaticOrder S; S.init(NTOK, INWP, nb, bid);
      EpiWin E{P, G, p.in[I_BG] + (size_t)l * 8192};
      pg8::gemm_phase<EpiWin, pg8::StaticOrder, false>((PG8_LAS unsigned char*)smem, g, S, E, nullptr);
    }
    xcd_barrier(xb);
    REP_END
    REP_BEGIN(2)
    { PHASE_TID
    const int gw = bid * 8 + wave, nw = nb * 8;
    for (int r = gw; r < NKEY; r += nw) {
      if (r >= NTOK) {
        const int e = r - NTOK, b = e >> 9, j = e & 511;
        const int keyrow = 4096 + b * 1536 + 1024 + j;
        const float* ck = p.in[I_CCKV] + ((size_t)(b * 2 + l) * 512 + j) * 512;
#pragma unroll
        for (int i = 0; i < 2; i++) {
          const int c = i * 256 + lane * 4;
          f32x4 v = *(const f32x4*)(ck + c);
          u32x2 o; o.x = pk2(v.x, v.y); o.y = pk2(v.z, v.w);
          *(u32x2*)(KEYS + (size_t)keyrow * 512 + c) = o;
        }
        const float kv = p.in[I_CKPE][((size_t)(b * 2 + l) * 512 + j) * 64 + lane];
        const u16 kb = f2bf(kv);
#pragma unroll
        for (int h = 0; h < 4; h++) KM[(size_t)keyrow * 768 + h * 192 + 128 + lane] = kb;
        continue;
      }
      const int row = r;
      const bool isctx = row < 4096;
      const int seq = isctx ? (row >> 8) : 16 + ((row - 4096) >> 10);
      const int t = isctx ? (row & 255) : ((row - 4096) & 1023);
      const int L = isctx ? 256 : 1024;
      const int keyrow = isctx ? row : 4096 + (seq - 16) * 1536 + t;
      const u16* Pr = P + (size_t)row * PW;
      {
        const float* cw = p.in[I_GCONV] + (size_t)l * 5 * 1536;
        auto conv2 = [&](int ch) -> f32x2 {
          f32x2 a = {0.f, 0.f};
#pragma unroll
          for (int k = 0; k < 5; k++) {
            const int tt = t + k - 2;
            if (tt >= 0 && tt < L) {
              const f32x2 x = ld2b(Pr + (ptrdiff_t)(k - 2) * PW + ch);
              const f32x2 w = *(const f32x2*)(cw + k * 1536 + ch);
              a = __builtin_elementwise_fma(x, w, a);
            }
          }
          a.x = silu(a.x); a.y = silu(a.y);
          return a;
        };
#pragma unroll 2
        for (int h = 0; h < 4; h++) {
          const int ch = h * 128 + lane * 2;
          f32x2 q = conv2(ch), k = conv2(512 + ch);
          const float sq = wave_sum(q.x * q.x + q.y * q.y), sk = wave_sum(k.x * k.x + k.y * k.y), qk = wave_sum(q.x * k.x + q.y * k.y);
          const float rq = rsqrtf(sq + EPS) * 0.08838834764831845f, rk = rsqrtf(sk + EPS);
          *(f32x2*)(GDQ + (size_t)row * 512 + ch) = q * rq;
          *(f32x2*)(GDK + (size_t)row * 512 + ch) = k * rk;
          if (lane == 0) GDKQ[(size_t)row * 4 + h] = qk * rq * rk;
        }
#pragma unroll 2
        for (int j = 0; j < 4; j++) {
          const int ch = j * 128 + lane * 2;
          *(f32x2*)(GDV + (size_t)row * 512 + ch) = conv2(1024 + ch);
        }
        if (lane < 8) {
          const int dir = lane >> 2, h = lane & 3;
          float bb = sigm(bf2f(Pr[C_GDB + lane]));
          float aa = bf2f(Pr[C_GDA + lane]);
          const float sx = aa + p.in[I_GDT][l * 8 + lane];
          const float sp_ = sx > 20.f ? sx : __logf(1.f + __expf(sx));
          float g = -__expf(p.in[I_GALOG][l * 8 + lane]) * sp_;
          GDEG[((size_t)dir * NTOK + row) * 4 + h] = __expf(g);
          GDBT[((size_t)dir * NTOK + row) * 4 + h] = bb;
        }
      }
      {
#pragma unroll
        for (int dir = 0; dir < 2; dir++) {
          const float* w2 = p.in[I_GLW2] + ((size_t)(l * 2 + dir) * 16) * 256 + lane * 4;
          f32x4 lg = *(const f32x4*)(p.in[I_GLB] + (l * 2 + dir) * 256 + lane * 4);
#pragma unroll
          for (int rr = 0; rr < 16; rr++) {
            const float gl = bf2f(Pr[C_GLG + dir * 16 + rr]);
            const f32x4 w = *(const f32x4*)(w2 + rr * 256);
            lg = lg + w * gl;
          }
          f32x4 o;
          o.x = __expf(__logf(sigm(lg.x)) * (1.f / 16.f));
          o.y = __expf(__logf(sigm(lg.y)) * (1.f / 16.f));
          o.z = __expf(__logf(sigm(lg.z)) * (1.f / 16.f));
          o.w = __expf(__logf(sigm(lg.w)) * (1.f / 16.f));
          *(f32x4*)(GLAA + ((size_t)dir * NTOK + row) * 256 + lane * 4) = o;
        }
      }
      {
        const f32x4 q0 = ld4b(Pr + C_MQA + lane * 4), q1 = ld4b(Pr + C_MQA + 256 + lane * 4);
        const f32x4 k0 = ld4b(Pr + C_MKV + lane * 4), k1 = ld4b(Pr + C_MKV + 256 + lane * 4);
        float ss = wave_sum(q0.x * q0.x + q0.y * q0.y + q0.z * q0.z + q0.w * q0.w + q1.x * q1.x + q1.y * q1.y + q1.z * q1.z + q1.w * q1.w);
        float rn = rsqrtf(ss * (1.f / 512.f) + EPS);
        const float* qn = p.in[I_QNORM] + l * 512;
        {
          const f32x4 n0 = *(const f32x4*)(qn + lane * 4), n1 = *(const f32x4*)(qn + 256 + lane * 4);
          const f32x4 a0 = q0 * rn * n0, a1 = q1 * rn * n1;
          u32x2 o; o.x = pk2(a0.x, a0.y); o.y = pk2(a0.z, a0.w);
          *(u32x2*)(AQ + (size_t)row * 512 + lane * 4) = o;
          o.x = pk2(a1.x, a1.y); o.y = pk2(a1.z, a1.w);
          *(u32x2*)(AQ + (size_t)row * 512 + 256 + lane * 4) = o;
        }
        ss = wave_sum(k0.x * k0.x + k0.y * k0.y + k0.z * k0.z + k0.w * k0.w + k1.x * k1.x + k1.y * k1.y + k1.z * k1.z + k1.w * k1.w);
        rn = rsqrtf(ss * (1.f / 512.f) + EPS);
        const float* kn = p.in[I_KVNORM] + l * 512;
        {
          const f32x4 n0 = *(const f32x4*)(kn + lane * 4), n1 = *(const f32x4*)(kn + 256 + lane * 4);
          const f32x4 c0 = k0 * rn * n0, c1 = k1 * rn * n1;
          u32x2 o; o.x = pk2(c0.x, c0.y); o.y = pk2(c0.z, c0.w);
          *(u32x2*)(KEYS + (size_t)keyrow * 512 + lane * 4) = o;
          o.x = pk2(c1.x, c1.y); o.y = pk2(c1.z, c1.w);
          *(u32x2*)(KEYS + (size_t)keyrow * 512 + 256 + lane * 4) = o;
          if (isctx) {
            float* oc = p.out + O_CKV + ((size_t)(seq * 2 + l) * 256 + t) * 512;
            *(f32x4*)(oc + lane * 4) = c0; *(f32x4*)(oc + 256 + lane * 4) = c1;
          }
        }
        {
          const int c = lane;
          float val;
          if (isctx) {
            val = bf2f(Pr[C_MKP + c]);
            p.out[O_KPE + ((size_t)(seq * 2 + l) * 256 + t) * 64 + c] = val;
          } else {
            const int hf = c >> 5, i = c & 15, second = (c >> 4) & 1;
            float x1 = bf2f(Pr[C_MKP + hf * 32 + i]), x2 = bf2f(Pr[C_MKP + hf * 32 + 16 + i]);
            float pos = hf ? (float)(t & 63) : (float)(t >> 6);
            float ang = pos * expf(-(float)i * (9.210340371976184f / 16.f));
            float sn, cs; sincosf(ang, &sn, &cs);
            val = second ? (x1 * sn + x2 * cs) : (x1 * cs - x2 * sn);
          }
          const u16 kb = f2bf(val);
#pragma unroll
          for (int h = 0; h < 4; h++) KM[(size_t)keyrow * 768 + h * 192 + 128 + c] = kb;
        }
      }
    }
    }
    xcd_barrier(xb);
    REP_END
    REP_BEGIN(6)
    { PHASE_TID
    for (int t = bid; t < 144 + 112 + 112; t += nb) {
      f32x16 acc[2][2]; zero_acc(acc);
      if (t < 144) {
        const int m0 = (t % 24) * 256, n0 = (t / 24) * 128;
        gemm_main(AQ + (size_t)m0 * 512, 512, WQT + (size_t)l * 768 * 512 + (size_t)n0 * 512, 512, 512, acc, sA, sB);
        const bool dec = m0 >= 4096;
        const int lane_ = lane, wm_ = wave >> 1, wn_ = wave & 1;
#pragma unroll
        for (int mi = 0; mi < 2; mi++)
#pragma unroll
          for (int ni = 0; ni < 2; ni++) {
            const int colbase = n0 + wn_ * 64 + ni * 32;
            const int c0 = colbase % 192;
            const bool pe = dec && (c0 >= 128);
#pragma unroll
            for (int r = 0; r < 16; r++) {
              const int row = m0 + wm_ * 64 + mi * 32 + (r & 3) + 8 * (r >> 2) + 4 * (lane_ >> 5);
              const int col = colbase + (lane_ & 31);
              float av = acc[mi][ni][r];
              if (pe) {
                float other = __shfl_xor(av, 16);
                const int tt = (row - 4096) & 1023;
                const int i = lane_ & 15, second = (lane_ >> 4) & 1;
                float pos = (c0 >= 160) ? (float)(tt & 63) : (float)(tt >> 6);
                float ang = pos * expf(-(float)i * (9.210340371976184f / 16.f));
                float sn, cs; sincosf(ang, &sn, &cs);
                av = second ? (other * sn + av * cs) : (av * cs - other * sn);
              }
              QM[(size_t)row * 768 + col] = f2bf(av);
            }
          }
      } else if (t < 256) {
        const int tt = t - 144;
        const int m0 = (tt % 28) * 256, n0 = (tt / 28) * 128;
        gemm_main(KEYS + (size_t)m0 * 512, 512, WKVT + (size_t)l * 1024 * 512 + (size_t)n0 * 512, 512, 512, acc, sA, sB);
        EPI_BEGIN
          KM[(size_t)row * 768 + (col >> 7) * 192 + (col & 127)] = f2bf(av);
        EPI_END
      } else {
        const int tt = t - 256;
        const int m0 = (tt & 1) * 256, n0 = (tt >> 1) * 128;
        gemm_main(WKVT + (size_t)l * 1024 * 512 + (size_t)(512 + m0) * 512, 512, KEYS + (size_t)n0 * 512, 512, 512, acc, sA, sB);
        EPI_BEGIN
          VT[(size_t)row * NKEY + col] = f2bf(av);
        EPI_END
      }
    }
    }
    xcd_barrier(xb);
    REP_END
    REP_BEGIN(6)
    { PHASE_TID
    for (int t = bid; t < 128 + 384; t += nb) {
      f32x16 acc[2][2]; zero_acc(acc);
      int m0, n0; const u16 *Ap, *Bp; float* Cp; int ldc;
      if (t < 128) {
        const int sh = t >> 1, seq = sh >> 2, h = sh & 3;
        m0 = 0; n0 = (t & 1) * 128;
        Ap = QM + (size_t)(seq * 256) * 768 + h * 192; Bp = KM + (size_t)(seq * 256) * 768 + h * 192;
        Cp = SC + (size_t)sh * 256 * 256; ldc = 256;
      } else {
        const int tt = t - 128, bh = tt / 48, rem = tt % 48, b = bh >> 2, h = bh & 3;
        m0 = (rem / 12) * 256; n0 = (rem % 12) * 128;
        Ap = QM + (size_t)(4096 + b * 1024) * 768 + h * 192; Bp = KM + (size_t)(4096 + b * 1536) * 768 + h * 192;
        Cp = SC + (size_t)4194304 + (size_t)bh * 1024 * 1536; ldc = 1536;
      }
      gemm_main(Ap + (size_t)m0 * 768, 768, Bp + (size_t)n0 * 768, 768, 192, acc, sA, sB);
      EPI_BEGIN
        Cp[(size_t)row * ldc + col] = av;
      EPI_END
    }
    }
    xcd_barrier(xb);
    REP_END
    REP_BEGIN(6)
    { PHASE_TID
      const float scale = 0.07216878364870323f;
      const int gw = bid * 8 + wave, nw = nb * 8;
      for (int r = gw; r < 16384; r += nw) {
        f32x4 v = *(const f32x4*)(SC + (size_t)r * 256 + lane * 4);
        float m = wave_max(fmaxf(fmaxf(v.x, v.y), fmaxf(v.z, v.w)));
        v.x = __expf((v.x - m) * scale); v.y = __expf((v.y - m) * scale);
        v.z = __expf((v.z - m) * scale); v.w = __expf((v.w - m) * scale);
        float inv = 1.f / wave_sum(v.x + v.y + v.z + v.w);
        u32x2 o; o.x = pk2(v.x * inv, v.y * inv); o.y = pk2(v.z * inv, v.w * inv);
        *(u32x2*)(PM + (size_t)r * 256 + lane * 4) = o;
      }
      for (int r = gw; r < 8192; r += nw) {
        const float* sp = SC + (size_t)4194304 + (size_t)r * 1536;
        u16* pp = PM + (size_t)4194304 + (size_t)r * 1536;
        f32x4 v[6];
        float m = -3.0e38f;
#pragma unroll
        for (int j = 0; j < 6; j++) {
          v[j] = *(const f32x4*)(sp + j * 256 + lane * 4);
          m = fmaxf(m, fmaxf(fmaxf(v[j].x, v[j].y), fmaxf(v[j].z, v[j].w)));
        }
        m = wave_max(m);
        float s = 0.f;
#pragma unroll
        for (int j = 0; j < 6; j++) {
          v[j].x = __expf((v[j].x - m) * scale); v[j].y = __expf((v[j].y - m) * scale);
          v[j].z = __expf((v[j].z - m) * scale); v[j].w = __expf((v[j].w - m) * scale);
          s += v[j].x + v[j].y + v[j].z + v[j].w;
        }
        float inv = 1.f / wave_sum(s);
#pragma unroll
        for (int j = 0; j < 6; j++) {
          u32x2 o; o.x = pk2(v[j].x * inv, v[j].y * inv); o.y = pk2(v[j].z * inv, v[j].w * inv);
          *(u32x2*)(pp + j * 256 + lane * 4) = o;
        }
      }
    }
    xcd_barrier(xb);
    REP_END
    REP_BEGIN(3)
    { PHASE_TID
    for (int t = bid; t < 64 + 32; t += nb) {
      f32x16 acc[2][2]; zero_acc(acc);
      int m0, K, rowbase, h; const u16 *Ap, *Bp;
      if (t < 64) {
        const int sh = t, seq = sh >> 2; h = sh & 3;
        m0 = 0; K = 256; rowbase = seq * 256;
        Ap = PM + (size_t)sh * 256 * 256; Bp = VT + (size_t)(h * 128) * NKEY + seq * 256;
      } else {
        const int tt = t - 64, bh = tt >> 2, b = bh >> 2; h = bh & 3;
        m0 = (tt & 3) * 256; K = 1536; rowbase = 4096 + b * 1024;
        Ap = PM + (size_t)4194304 + (size_t)bh * 1024 * 1536; Bp = VT + (size_t)(h * 128) * NKEY + 4096 + b * 1536;
      }
      gemm_main(Ap + (size_t)m0 * K, K, Bp, NKEY, K, acc, sA, sB);
      const int n0 = 0;
      EPI_BEGIN
        BR[((size_t)3 * NTOK + rowbase + row) * LDB + h * 128 + col] = f2bf(av);
      EPI_END
    }
    }
    { PHASE_TID
    for (;;) {
      __syncthreads();
      if (tid == 0) *s_item = atomicAdd(&CNT[l + 2 * rep_], 1);
      __syncthreads();
      const int it = *s_item;
      if (it >= 480) break;
      int br, seq, h, dir, cb, isc;
      if (it < 96) { br = it >> 5; const int u = (it & 31) >> 1; cb = it & 1; seq = 16 + (u >> 3); h = (u >> 1) & 3; dir = u & 1; isc = 0; }
      else { const int j = it - 96; br = j >> 7; const int u = j & 127; cb = 0; seq = u >> 3; h = (u >> 1) & 3; dir = u & 1; isc = 1; }
      const int row0 = seq < 16 ? seq * 256 : 4096 + (seq - 16) * 1024;
      const int L = seq < 16 ? 256 : 1024;
      const int colbase = cb * 64;
      if (br == 0) {
        const float* S0 = nullptr; float* So = nullptr;
        if (seq >= 16) S0 = p.in[I_SGDN] + ((((size_t)(seq - 16) * 2 + l) * 2 + dir) * 4 + h) * 16384 + colbase;
        else So = p.out + O_SGDN + ((((size_t)seq * 2 + l) * 2 + dir) * 4 + h) * 16384;
        const float* Kp = GDK + (size_t)row0 * 512 + h * 128; const float* Qp = GDQ + (size_t)row0 * 512 + h * 128;
        const float* Vp = GDV + (size_t)row0 * 512 + h * 128 + colbase;
        const float* Eg = GDEG + ((size_t)dir * NTOK + row0) * 4 + h; const float* Bt = GDBT + ((size_t)dir * NTOK + row0) * 4 + h;
        float* Op = OBUF + ((size_t)(0 * 2 + dir) * NTOK + row0) * 512 + h * 128 + colbase;
        const float* KQ = GDKQ + (size_t)row0 * 4 + h;
        if (isc) rec_gdn<4>(Kp, Qp, Vp, Eg, Bt, KQ, Op, L, dir, S0, So, sf);
        else rec_gdn8(Kp, Qp, Vp, Eg, Bt, KQ, Op, L, dir, S0, sf);
      } else if (br == 1) {
        const float* S0 = nullptr; float* So = nullptr;
        if (seq >= 16) S0 = p.in[I_SHG] + ((((size_t)(seq - 16) * 2 + l) * 2 + dir) * 4 + h) * 16384 + colbase;
        else So = p.out + O_SHG + ((((size_t)seq * 2 + l) * 2 + dir) * 4 + h) * 16384;
        const u16* Ap = P + (size_t)row0 * PW + C_HGF + dir * 512 + h * 128; const u16* Kp = Ap;
        const u16* Qp = P + (size_t)row0 * PW + C_HGQ + h * 128;
        const float* lbp = (l == 1) ? p.in[I_HGLB] + dir * 512 + h * 128 : nullptr;
        const u16* Vp = P + (size_t)row0 * PW + C_HGI + h * 128 + colbase;
        float* Op = OBUF + ((size_t)(2 * 2 + dir) * NTOK + row0) * 512 + h * 128 + colbase;
        if (isc) rec_diag<128, 4, true>(Ap, PW, Kp, PW, Qp, PW, Vp, PW, Op, 1.f, L, dir, S0, So, sf, lbp);
        else rec_diag<128, 2, true>(Ap, PW, Kp, PW, Qp, PW, Vp, PW, Op, 1.f, L, dir, S0, So, sf, lbp);
      } else {
        const float* S0 = nullptr; float* So = nullptr;
        if (seq >= 16) S0 = p.in[I_SGLA] + ((((size_t)(seq - 16) * 2 + l) * 2 + dir) * 4 + h) * 8192 + colbase;
        else So = p.out + O_SGLA + ((((size_t)seq * 2 + l) * 2 + dir) * 4 + h) * 8192;
        const float* Ap = GLAA + ((size_t)dir * NTOK + row0) * 256 + h * 64;
        const u16* Kp = P + (size_t)row0 * PW + C_GLK + h * 64; const u16* Qp = P + (size_t)row0 * PW + C_GLQ + h * 64;
        const u16* Vp = P + (size_t)row0 * PW + C_GLV + h * 128 + colbase;
        float* Op = OBUF + ((size_t)(1 * 2 + dir) * NTOK + row0) * 512 + h * 128 + colbase;
        if (isc) rec_diag<64, 4>(Ap, 256, Kp, PW, Qp, PW, Vp, PW, Op, 0.125f, L, dir, S0, So, sf);
        else rec_diag<64, 2>(Ap, 256, Kp, PW, Qp, PW, Vp, PW, Op, 0.125f, L, dir, S0, So, sf);
      }
    }
    }
    xcd_barrier(xb);
    REP_END
    REP_BEGIN(7)
    { PHASE_TID
    const int gw = bid * 8 + wave, nw = nb * 8;
    for (int row = gw; row < NTOK; row += nw) {
      const u16* Pr = P + (size_t)row * PW;
      const int c8 = lane * 8, d8 = (lane & 15) * 8;
#pragma unroll
      for (int br = 0; br < 3; br++) {
        const float* nw_ = (br == 0 ? p.in[I_GNORM] : br == 1 ? p.in[I_GLNORM] : p.in[I_HGNORM]) + l * 128 + d8;
        const int gofs = br == 0 ? C_GDZ : br == 1 ? C_GLR : C_HGG;
        const float* of = OBUF + ((size_t)(br * 2 + 0) * NTOK + row) * 512 + c8;
        const float* ob = OBUF + ((size_t)(br * 2 + 1) * NTOK + row) * 512 + c8;
        const f32x4 o0 = *(const f32x4*)of + *(const f32x4*)ob, o1 = *(const f32x4*)(of + 4) + *(const f32x4*)(ob + 4);
        const u32x4 graw = *(const u32x4*)(Pr + gofs + c8);
        const f32x4 w0 = *(const f32x4*)nw_, w1 = *(const f32x4*)(nw_ + 4);
        float ss = (o0.x * o0.x + o0.y * o0.y) + (o0.z * o0.z + o0.w * o0.w) + (o1.x * o1.x + o1.y * o1.y) + (o1.z * o1.z + o1.w * o1.w);
        ss += dppmov<0x128>(ss); ss += dppmov<0x124>(ss); ss += dppmov<0x122>(ss); ss += dppmov<0x121>(ss);
        const float rn = rsqrtf(ss * (1.f / 128.f) + EPS);
        const f32x4 g0 = up4lo(graw), g1 = up4hi(graw);
        f32x4 t0, t1;
        if (br == 2) {
          t0.x = sigm(g0.x); t0.y = sigm(g0.y); t0.z = sigm(g0.z); t0.w = sigm(g0.w);
          t1.x = sigm(g1.x); t1.y = sigm(g1.y); t1.z = sigm(g1.z); t1.w = sigm(g1.w);
        } else {
          t0.x = silu(g0.x); t0.y = silu(g0.y); t0.z = silu(g0.z); t0.w = silu(g0.w);
          t1.x = silu(g1.x); t1.y = silu(g1.y); t1.z = silu(g1.z); t1.w = silu(g1.w);
        }
        const f32x4 r0 = o0 * rn * w0 * t0, r1 = o1 * rn * w1 * t1;
        u32x4 o; o.x = pk2(r0.x, r0.y); o.y = pk2(r0.z, r0.w); o.z = pk2(r1.x, r1.y); o.w = pk2(r1.z, r1.w);
        *(u32x4*)(BR + ((size_t)br * NTOK + row) * LDB + c8) = o;
      }
    }
    }
    xcd_barrier(xb);
    REP_END
    REP_BEGIN(5)
    {
      pg8::Gemm g{BR, WBRT + (size_t)l * 4 * 2048 * LDB, 4 * NTOK, 4 * 2048, 512, LDB, LDB};
      BranchOrder S{bid};
      EpiBranch E{MERGED, G};
      pg8::gemm_phase<EpiBranch, BranchOrder, false>((PG8_LAS unsigned char*)smem, g, S, E, nullptr);
      if (l == 0 && nb > 192 && bid >= 192) {
        transpose_job<1>(p.in[I_W1] + (size_t)2048 * DFF, 2048, DFF, W13T + (size_t)11264 * LDK, LDK, sf, bid - 192, nb - 192);
        transpose_job<2>(p.in[I_W3] + (size_t)2048 * DFF, 2048, DFF, W13T + (size_t)11264 * LDK, LDK, sf, bid - 192, nb - 192);
      }
    }
    xcd_barrier(xb);
    REP_END
    REP_BEGIN(4)
    {
      pg8::Gemm g{MERGED, WOUTT + (size_t)l * 2048 * LDK, NTOK, 2048, 2048, LDK, LDK};
      pg8::StaticOrder S; S.init(NTOK, 2048, nb, bid);
      EpiRes E{V, X2, modl + 4096};
      pg8::gemm_phase<EpiRes, pg8::StaticOrder, false>((PG8_LAS unsigned char*)smem, g, S, E, nullptr);
      if (l == 0 && nb > 192 && bid >= 192) {
        for (int k = 0; k < 4; k++)
          transpose_job<0>(p.in[I_WBR] + (size_t)(4 + k) * 512 * 2048, 512, 2048, WBRT + (size_t)(4 + k) * 2048 * LDB, LDB, sf, bid - 192, nb - 192);
        transpose_job<0>(p.in[I_WOUT] + (size_t)2048 * 2048, 2048, 2048, WOUTT + (size_t)2048 * LDK, LDK, sf, bid - 192, nb - 192);
      }
    }
    xcd_barrier(xb);
    REP_END
    REP_BEGIN(7)
    { PHASE_TID
    const int gw = bid * 8 + wave, nw = nb * 8;
    for (int row = gw; row < NTOK; row += nw) {
      const u16* vr = V + (size_t)row * 2048;
      f32x4 x[8]; float s1 = 0.f;
#pragma unroll
      for (int jj = 0; jj < 4; jj++) { const u32x4 raw = *(const u32x4*)(vr + jj * 512 + lane * 8); x[2 * jj] = up4lo(raw); x[2 * jj + 1] = up4hi(raw); }
#pragma unroll
      for (int j = 0; j < 8; j++) s1 += (x[j].x + x[j].y) + (x[j].z + x[j].w);
      const float mu = wave_sum(s1) * (1.f / 2048.f);
      float s2 = 0.f;
#pragma unroll
      for (int j = 0; j < 8; j++) { x[j] = x[j] - mu; s2 += (x[j].x * x[j].x + x[j].y * x[j].y) + (x[j].z * x[j].z + x[j].w * x[j].w); }
      const float rn = rsqrtf(wave_sum(s2) * (1.f / 2048.f) + EPS);
      const float* md = modl + (size_t)row_vidx(row) * 12288 + 6144;
#pragma unroll
      for (int jj = 0; jj < 4; jj++) {
        const int c = jj * 512 + lane * 8;
        f32x4 y[2]; u32x4 oy, oa;
#pragma unroll
        for (int hh = 0; hh < 2; hh++) {
          const int cc = c + hh * 4;
          const f32x4 gg = *(const f32x4*)(p.in[I_LN1G] + l * 2048 + cc), bb = *(const f32x4*)(p.in[I_LN1B] + l * 2048 + cc);
          y[hh] = x[2 * jj + hh] * rn * gg + bb;
          const f32x4 sh = *(const f32x4*)(md + cc), sc = *(const f32x4*)(md + 2048 + cc);
          const unsigned a0 = pk2(y[hh].x * (1.f + sc.x) + sh.x, y[hh].y * (1.f + sc.y) + sh.y), a1 = pk2(y[hh].z * (1.f + sc.z) + sh.z, y[hh].w * (1.f + sc.w) + sh.w);
          const unsigned y0 = pk2(y[hh].x, y[hh].y), y1 = pk2(y[hh].z, y[hh].w);
          if (hh == 0) { oy.x = y0; oy.y = y1; oa.x = a0; oa.y = a1; } else { oy.z = y0; oy.w = y1; oa.z = a0; oa.w = a1; }
        }
        *(u32x4*)(X1 + (size_t)row * 2048 + c) = oy;
        *(u32x4*)(XA + (size_t)row * LDK + c) = oa;
      }
    }
    }
    xcd_barrier(xb);
    REP_END
    REP_BEGIN(4)
    {
      pg8::Gemm g{XA, W13T + (size_t)l * 11264 * LDK, NTOK, 11264, 2048, LDK, LDK};
      pg8::StaticOrder S; S.init(NTOK, 11264, nb, bid);
      EpiFfn1 E{ACT};
      pg8::gemm_phase<EpiFfn1, pg8::StaticOrder, false>((PG8_LAS unsigned char*)smem, g, S, E, nullptr);
    }
    xcd_barrier(xb);
    REP_END
    REP_BEGIN(4)
    {
      pg8::Gemm g{ACT, W2T + (size_t)l * 2048 * LDF, NTOK, 2048, DFF, LDF, LDF};
      pg8::StaticOrder S; S.init(NTOK, 2048, nb, bid);
      EpiRes E{V, X1, modl + 10240};
      pg8::gemm_phase<EpiRes, pg8::StaticOrder, false>((PG8_LAS unsigned char*)smem, g, S, E, nullptr);
      if (l == 0 && nb > 192 && bid >= 192) {
        transpose_job<0>(p.in[I_W2] + (size_t)DFF * 2048, DFF, 2048, W2T + (size_t)2048 * LDF, LDF, sf, bid - 192, nb - 192);
        transpose_job<0>(p.in[I_WIN] + (size_t)2048 * INW, 2048, INW, WINT + (size_t)INWP * LDK, LDK, sf, bid - 192, nb - 192, 0, 1920);
      }
    }
    xcd_barrier(xb);
    REP_END

    { PHASE_TID
    const int gw = bid * 8 + wave, nw = nb * 8;
    for (int row = gw; row < NTOK; row += nw) {
      const u16* vr = V + (size_t)row * 2048;
      f32x4 x[8]; float s1 = 0.f;
#pragma unroll
      for (int jj = 0; jj < 4; jj++) { const u32x4 raw = *(const u32x4*)(vr + jj * 512 + lane * 8); x[2 * jj] = up4lo(raw); x[2 * jj + 1] = up4hi(raw); }
#pragma unroll
      for (int j = 0; j < 8; j++) s1 += (x[j].x + x[j].y) + (x[j].z + x[j].w);
      const float mu = wave_sum(s1) * (1.f / 2048.f);
      float s2 = 0.f;
#pragma unroll
      for (int j = 0; j < 8; j++) { x[j] = x[j] - mu; s2 += (x[j].x * x[j].x + x[j].y * x[j].y) + (x[j].z * x[j].z + x[j].w * x[j].w); }
      const float rn = rsqrtf(wave_sum(s2) * (1.f / 2048.f) + EPS);
      const float* md = MOD + (size_t)(3 + row_vidx(row)) * 12288;
#pragma unroll
      for (int jj = 0; jj < 4; jj++) {
        const int c = jj * 512 + lane * 8;
        u32x4 oy, oa;
#pragma unroll
        for (int hh = 0; hh < 2; hh++) {
          const int cc = c + hh * 4;
          const f32x4 gg = *(const f32x4*)(p.in[I_LN2G] + l * 2048 + cc), bb = *(const f32x4*)(p.in[I_LN2B] + l * 2048 + cc);
          const f32x4 y = x[2 * jj + hh] * rn * gg + bb;
          if (l == 1) *(f32x4*)(p.out + O_Y + (size_t)row * 2048 + cc) = y;
          else {
            const f32x4 sh = *(const f32x4*)(md + cc), sc = *(const f32x4*)(md + 2048 + cc);
            const unsigned a0 = pk2(y.x * (1.f + sc.x) + sh.x, y.y * (1.f + sc.y) + sh.y), a1 = pk2(y.z * (1.f + sc.z) + sh.z, y.w * (1.f + sc.w) + sh.w);
            const unsigned y0 = pk2(y.x, y.y), y1 = pk2(y.z, y.w);
            if (hh == 0) { oy.x = y0; oy.y = y1; oa.x = a0; oa.y = a1; } else { oy.z = y0; oy.w = y1; oa.z = a0; oa.w = a1; }
          }
        }
        if (l == 0) {
          *(u32x4*)(X2 + (size_t)row * 2048 + c) = oy;
          *(u32x4*)(XA + (size_t)row * LDK + c) = oa;
        }
      }
    }
    }
    if (l == 0) xcd_barrier(xb);
  }
}

extern "C" void kernel_launch(void* const* d_in, const int* in_sizes, int n_in, void* d_out, int out_size, void* d_ws,
                              size_t ws_size, hipStream_t stream) {
  if (ws_size < W_END) { fprintf(stderr, "workspace too small: %zu < %zu\n", ws_size, (size_t)W_END); return; }
  static int grid_blocks = 0;
  if (!grid_blocks) {
    int dev = 0, cus = 0, per_cu = 0;
    (void)hipGetDevice(&dev);
    (void)hipDeviceGetAttribute(&cus, hipDeviceAttributeMultiprocessorCount, dev);
    (void)hipFuncSetAttribute((const void*)mega, hipFuncAttributeMaxDynamicSharedMemorySize, (int)LDS_BYTES);
    (void)hipOccupancyMaxActiveBlocksPerMultiprocessor(&per_cu, mega, NT, LDS_BYTES);
    if (per_cu > 1) per_cu = 1;
    if (per_cu < 1) per_cu = 1;
    grid_blocks = cus * per_cu;
  }
  Params p{};
  for (int i = 0; i < 35; i++) p.in[i] = (const float*)d_in[i];
  p.out = (float*)d_out;
  p.ws = (char*)d_ws;
  (void)hipMemsetAsync((char*)d_ws + W_CNT, 0, 256 + al((size_t)XCD_BAR_WORDS * 4), stream);
  void* args[] = {&p};
  hipError_t e = hipLaunchCooperativeKernel((void*)mega, dim3(grid_blocks), dim3(NT), args, LDS_BYTES, stream);
  if (e != hipSuccess) fprintf(stderr, "cooperative launch failed: %s (grid %d)\n", hipGetErrorString(e), grid_blocks);
}
```

```cpp
#include <hip/hip_runtime.h>
#include <hip/hip_cooperative_groups.h>
#include <cstdio>
#include <cstdint>
namespace cg = cooperative_groups;

typedef unsigned short u16;
using bf16x8 = __attribute__((ext_vector_type(8))) short;
using f32x16 = __attribute__((ext_vector_type(16))) float;
using u32x4 = __attribute__((ext_vector_type(4))) unsigned;
using u32x2 = __attribute__((ext_vector_type(2))) unsigned;
using f32x4 = __attribute__((ext_vector_type(4))) float;
using f32x2 = __attribute__((ext_vector_type(2))) float;
#define DEV __device__ __forceinline__
#ifndef PROBE_ID
#define PROBE_ID 0
#endif
#define REP_BEGIN(id) for (int rep_ = 0; rep_ < ((PROBE_ID == (id)) ? 2 : 1); rep_++) {
#define REP_END }

namespace pg8 {
#define PG8_LAS __attribute__((address_space(3)))
typedef unsigned short bf16_t;
typedef short bf16x8 __attribute__((ext_vector_type(8)));
typedef float f32x4 __attribute__((ext_vector_type(4)));
typedef unsigned u32x4 __attribute__((ext_vector_type(4)));
constexpr int BM = 256, BK = 64, HALF = 128, HTB = HALF * BK * 2  , STAGE_BYTES = 8 * HTB, NXCD = 8, WGM = 8;

__host__ __device__ __forceinline__ int lds_byte(int r, int c) { const int st = (r >> 4) * 2 + (c >> 5), rr = r & 15, cc = c & 31, ob = rr * 64 + cc * 2; return st * 1024 + (ob ^ (((ob >> 9) & 1) << 5)); }
__host__ __device__ __forceinline__ void stage_rc(int b, int& R, int& C) { const int st = b / 1024, sb = b % 1024, swz = sb ^ (((sb >> 9) & 1) << 5); R = (st >> 1) * 16 + swz / 64; C = (st & 1) * 32 + (swz % 64) / 2; }
__host__ __device__ __forceinline__ int perm32(int rho) { const int n = rho >> 4, i = rho & 15; return 8 * (i >> 2) + 4 * n + (i & 3); }

struct Unit { int pm, pn; };
struct Gemm { const bf16_t* A; const bf16_t* Bt; int M, N, K; int lda, ldb; };

struct StaticOrder {
    int nM, nN, nwg, G, c;
    __host__ __device__ void init(int M, int N, int G_, int c_) { nM = M / BM; nN = N / BM; nwg = nM * nN; G = G_; c = c_; }
    __host__ __device__ bool next(int i, Unit& u) const {
        const long L = (long)i * G + c; if (L >= nwg) return false;
        int wgid = (int)L; { const int q = nwg / NXCD, r = nwg % NXCD, xcd = wgid % NXCD, off = wgid / NXCD; wgid = (xcd < r ? xcd * (q + 1) : r * (q + 1) + (xcd - r) * q) + off; }
        const int nig = WGM * nN, gid = wgid / nig, fm = gid * WGM, gsz = (nM - fm) < WGM ? (nM - fm) : WGM;
        u.pm = fm + ((wgid % nig) % gsz); u.pn = (wgid % nig) / gsz; return true;
    }
    __device__ __forceinline__ void a_ready(const Unit&) const {}
    __device__ __forceinline__ void done(const Unit&) const {}
};
template <class Epi, class Sched, bool STAMP = false>
__device__ __forceinline__ void gemm_phase(PG8_LAS unsigned char* lds, const Gemm g, const Sched& S, const Epi& E, unsigned long long* stamps) {
    int tid = threadIdx.x; asm volatile("" : "+v"(tid)); const int wid = __builtin_amdgcn_readfirstlane(tid >> 6), lane = tid & 63, wr = wid >> 2, wc = wid & 3, fr = lane & 15, fq = lane >> 4;
    const int K = g.K, nt = K / BK;
    int ts_lo = 0, ts_hi = 0, nts = 0; const unsigned long long rt_entry = STAMP ? (unsigned long long)wall_clock64() : 0ull;
#define PG8_STAMP() do { if (STAMP && wid == 0 && nts < 64) { const unsigned long long _c = (unsigned long long)clock64(); \
        ts_lo = (lane == nts) ? (int)(unsigned)_c : ts_lo; ts_hi = (lane == nts) ? (int)(unsigned)(_c >> 32) : ts_hi; ++nts; } } while (0)
    PG8_STAMP();
    unsigned voffA[2], voffB[2];
#pragma unroll
    for (int i = 0; i < 2; ++i) { int R, C; stage_rc(tid * 16 + i * 8192, R, C); const int Rb = Epi::PERM ? ((R & ~31) + perm32(R & 31)) : R;
        voffA[i] = (unsigned)(R * g.lda + C) * 2u; voffB[i] = (unsigned)(Rb * g.ldb + C) * 2u; }
    const size_t kstep = (size_t)(BK * 2);
    const size_t hstepA = (size_t)HALF * g.lda * 2, hstepB = (size_t)HALF * g.ldb * 2;
    const size_t tstepA = 2 * hstepA, tstepB = 2 * hstepB;
    const unsigned ldsw = (unsigned)wid * 1024u;
    const int aoff = lds_byte(wr * 64 + fr, fq * 8), boff = lds_byte(wc * 32 + fr, fq * 8);
#define PG8_SA(b, h) (((b) * 2 + (h)) * HTB)
#define PG8_SB(b, h) ((4 + (b) * 2 + (h)) * HTB)
#define PG8_STAGE(bufoff, gbase, voff) do { _Pragma("unroll") for (int _i = 0; _i < 2; ++_i) \
        __builtin_amdgcn_global_load_lds((const unsigned*)((const char*)(gbase) + (voff)[_i]), (PG8_LAS unsigned*)(lds + (bufoff) + ldsw + _i * 8192), 16, 0, 0); } while (0)
#define PG8_LDA(dst, b, h) do { _Pragma("unroll") for (int m = 0; m < 4; ++m) _Pragma("unroll") for (int k = 0; k < 2; ++k) dst[m][k] = *(const PG8_LAS bf16x8*)(lds + PG8_SA(b, h) + aoff + m * 2048 + k * 1024); } while (0)
#define PG8_LDB(dst, b, h) do { _Pragma("unroll") for (int n = 0; n < 2; ++n) _Pragma("unroll") for (int k = 0; k < 2; ++k) dst[n][k] = *(const PG8_LAS bf16x8*)(lds + PG8_SB(b, h) + boff + n * 2048 + k * 1024); } while (0)
#define PG8_MMA(ai, bj, At, Bt) do { __builtin_amdgcn_s_setprio(1); _Pragma("unroll") for (int m = 0; m < 4; ++m) _Pragma("unroll") for (int n = 0; n < 2; ++n) _Pragma("unroll") for (int k = 0; k < 2; ++k) \
        acc[ai][bj][m][n] = __builtin_amdgcn_mfma_f32_16x16x32_bf16(Bt[n][k], At[m][k], acc[ai][bj][m][n], 0, 0, 0); __builtin_amdgcn_s_setprio(0); } while (0)
#define PG8_WAIT_V(n) asm volatile("s_waitcnt vmcnt(" #n ")" ::: "memory")
#define PG8_WAIT_L(n) asm volatile("s_waitcnt lgkmcnt(" #n ")" ::: "memory")
#define PG8_BAR __builtin_amdgcn_s_barrier()
#define PG8_SCHED __builtin_amdgcn_sched_barrier(0)
    Unit cur, nxt; int ui = 0;
    if (!S.next(0, cur)) return;
    f32x4 acc[2][2][4][2];
#pragma unroll
    for (int a = 0; a < 2; ++a)
#pragma unroll
        for (int b = 0; b < 2; ++b)
#pragma unroll
            for (int m = 0; m < 4; ++m)
#pragma unroll
                for (int n = 0; n < 2; ++n) acc[a][b][m][n] = (f32x4){0.f, 0.f, 0.f, 0.f};
    bf16x8 At[4][2], B0[2][2], B1[2][2];
    const char* cA = (const char*)g.A + (size_t)cur.pm * tstepA; const char* cB = (const char*)g.Bt + (size_t)cur.pn * tstepB;
    S.a_ready(cur);
    PG8_STAGE(PG8_SB(0, 0), cB, voffB); PG8_STAGE(PG8_SA(0, 0), cA, voffA); PG8_STAGE(PG8_SB(0, 1), cB + hstepB, voffB); PG8_STAGE(PG8_SA(0, 1), cA + hstepA, voffA);
    if (wr == 1) PG8_BAR;
    PG8_WAIT_V(4); PG8_BAR;
    PG8_STAGE(PG8_SB(1, 0), cB + kstep, voffB); PG8_STAGE(PG8_SA(1, 0), cA + kstep, voffA); PG8_STAGE(PG8_SB(1, 1), cB + hstepB + kstep, voffB);
    PG8_WAIT_V(6); PG8_BAR;
    PG8_STAMP();
    for (;;) {
        const bool has_next = S.next(ui + 1, nxt);
        const char* nA = has_next ? (const char*)g.A + (size_t)nxt.pm * tstepA : cA; const char* nB = has_next ? (const char*)g.Bt + (size_t)nxt.pn * tstepB : cB;
        for (int t = 0; t < nt; t += 2) {
            const bool last = (t == nt - 2);
            const char* a1 = cA + (size_t)(t + 1) * kstep;
            const char* a2 = last ? nA : cA + (size_t)(t + 2) * kstep; const char* b2 = last ? nB : cB + (size_t)(t + 2) * kstep;
            const char* a3 = a2 + kstep; const char* b3 = b2 + kstep;
            if (last && has_next) S.a_ready(nxt);
            PG8_LDB(B0, 0, 0); PG8_SCHED; PG8_LDA(At, 0, 0); PG8_STAGE(PG8_SA(1, 1), a1 + hstepA, voffA);
            PG8_WAIT_L(8); PG8_BAR; PG8_WAIT_L(0); PG8_MMA(0, 0, At, B0); PG8_BAR; PG8_SCHED;
            PG8_LDB(B1, 0, 1); PG8_STAGE(PG8_SB(0, 0), b2, voffB);
            PG8_BAR; PG8_WAIT_L(0); PG8_MMA(0, 1, At, B1); PG8_BAR;
            PG8_LDA(At, 0, 1); PG8_STAGE(PG8_SA(0, 0), a2, voffA);
            PG8_BAR; PG8_WAIT_L(0); PG8_MMA(1, 0, At, B0); PG8_BAR; PG8_SCHED;
            PG8_STAGE(PG8_SB(0, 1), b2 + hstepB, voffB);
            PG8_WAIT_V(6); PG8_BAR; PG8_MMA(1, 1, At, B1); PG8_BAR;
            PG8_LDB(B0, 1, 0); PG8_SCHED; PG8_LDA(At, 1, 0); PG8_STAGE(PG8_SA(0, 1), a2 + hstepA, voffA);
            PG8_WAIT_L(8); PG8_BAR; PG8_WAIT_L(0); PG8_MMA(0, 0, At, B0); PG8_BAR; PG8_SCHED;
            PG8_LDB(B1, 1, 1); PG8_STAGE(PG8_SB(1, 0), b3, voffB);
            PG8_BAR; PG8_WAIT_L(0); PG8_MMA(0, 1, At, B1); PG8_BAR;
            PG8_LDA(At, 1, 1); PG8_STAGE(PG8_SA(1, 0), a3, voffA);
            PG8_BAR; PG8_WAIT_L(0); PG8_MMA(1, 0, At, B0); PG8_BAR; PG8_SCHED;
            PG8_STAGE(PG8_SB(1, 1), b3 + hstepB, voffB);
            PG8_WAIT_V(6); PG8_BAR; PG8_MMA(1, 1, At, B1); PG8_BAR;
        }
        PG8_STAMP();
        if constexpr (!Epi::AFTER_DRAIN) { E(acc, cur, wr, wc, fr, fq); S.done(cur); }
        PG8_STAMP();
        if (!has_next) break;
        if constexpr (!Epi::KEEP) {
#pragma unroll
        for (int a = 0; a < 2; ++a)
#pragma unroll
            for (int b = 0; b < 2; ++b)
#pragma unroll
                for (int m = 0; m < 4; ++m)
#pragma unroll
                    for (int n = 0; n < 2; ++n) acc[a][b][m][n] = (f32x4){0.f, 0.f, 0.f, 0.f};
        }
        cur = nxt; cA = nA; cB = nB; ++ui;
    }
    PG8_WAIT_V(0);
    if (wr == 0) PG8_BAR;
    PG8_BAR;
    if constexpr (Epi::AFTER_DRAIN) { E.fused(acc, cur, wr, wc, fr, fq, lds, wid, lane); S.done(cur); }
    PG8_STAMP();
    if (STAMP && wid == 0) { stamps[lane] = lane < nts ? (((unsigned long long)(unsigned)ts_hi << 32) | (unsigned)ts_lo) : 0ull;
        if (lane == 62) stamps[62] = rt_entry; if (lane == 63) stamps[63] = (unsigned long long)wall_clock64(); }
#undef PG8_STAMP
#undef PG8_SA
#undef PG8_SB
#undef PG8_STAGE
#undef PG8_LDA
#undef PG8_LDB
#undef PG8_MMA
#undef PG8_WAIT_V
#undef PG8_WAIT_L
#undef PG8_BAR
#undef PG8_SCHED
}
}


#define XB_TMO      128
#define XB_XCNT(j)  (256  + 64 * (j))
#define XB_XSUB(j)  (1280 + 64 * (j))
#define XB_XGEN(j)  (2304 + 64 * (j))
#define XB_TOP      3328
#define XB_TOPGEN   3392
#define XCD_BAR_WORDS 3456
#define XB_SPIN_CAP (1u << 18)
#define LAS __attribute__((address_space(3)))

__device__ __forceinline__ unsigned xb_ld(unsigned* p)              { return __hip_atomic_load(p, __ATOMIC_RELAXED, __HIP_MEMORY_SCOPE_AGENT); }
__device__ __forceinline__ unsigned xb_add(unsigned* p, unsigned v) { return __hip_atomic_fetch_add(p, v, __ATOMIC_RELAXED, __HIP_MEMORY_SCOPE_AGENT); }
__device__ __forceinline__ unsigned xb_xcc_id() { return (unsigned)__builtin_amdgcn_s_getreg((3 << 11) | 20) & 0xFu; }
#define XB_SPIN(cond, bar) do { unsigned _sp = 0; while (cond) { __builtin_amdgcn_s_sleep(1); \
    if ((++_sp & 255u) == 0u) { if (xb_ld(&(bar)[XB_TMO])) break; if (_sp > XB_SPIN_CAP) { atomicAdd(&(bar)[XB_TMO], 1u); break; } } } } while (0)

struct XcdBarrier {
    unsigned* bar; unsigned x;
    volatile LAS unsigned* st;
};

__device__ __forceinline__ XcdBarrier xcd_barrier_post(unsigned* bar, volatile LAS unsigned* st) {
    XcdBarrier b; b.bar = bar; b.x = xb_xcc_id(); b.st = st;
    if (threadIdx.x == 0) (void)xb_add(&bar[XB_XCNT(b.x)], 1u);
    return b;
}
__device__ __forceinline__ void xcd_barrier_complete(unsigned* bar, unsigned x, unsigned& nloc, unsigned& nx) {
    const unsigned G = gridDim.x * gridDim.y * gridDim.z;
    unsigned sum, cnt, mine, sp = 0u;
    for (;;) {
        sum = 0u; cnt = 0u; mine = 0u;
#pragma unroll
        for (unsigned j = 0; j < 16; ++j) { const unsigned c = xb_ld(&bar[XB_XCNT(j)]); sum += c; cnt += (c > 0u) ? 1u : 0u; mine = (j == x) ? c : mine; }
        if (sum == G) break;
        __builtin_amdgcn_s_sleep(1);
        if ((++sp & 255u) == 0u) { if (xb_ld(&bar[XB_TMO])) break; if (sp > XB_SPIN_CAP) { atomicAdd(&bar[XB_TMO], 1u); break; } }
    }
    nloc = mine > 0u ? mine : 1u; nx = cnt > 0u ? cnt : 1u;
}

__device__ __forceinline__ void xcd_barrier(const XcdBarrier& b) {
    asm volatile("s_waitcnt vmcnt(0)" ::: "memory");
    __syncthreads();
    if (threadIdx.x == 0) {
        unsigned* bar = b.bar; const unsigned bx = xb_xcc_id();
        __builtin_amdgcn_s_waitcnt(0);
        unsigned nloc = b.st[0], nx = b.st[1];
        if (nloc == 0u) { xcd_barrier_complete(bar, bx, nloc, nx); b.st[0] = nloc; b.st[1] = nx; }
        const unsigned old = xb_add(&bar[XB_XSUB(bx)], 1u);
        const unsigned gen = old / nloc;
        if (old + 1u == (gen + 1u) * nloc) {
            __builtin_amdgcn_fence(__ATOMIC_RELEASE, "agent");
            asm volatile("s_waitcnt vmcnt(0)" ::: "memory");
            const unsigned og = xb_add(&bar[XB_TOP], 1u);
            const unsigned tg = og / nx;
            if (og + 1u == (tg + 1u) * nx) xb_add(&bar[XB_TOPGEN], 1u);
            else XB_SPIN(xb_ld(&bar[XB_TOPGEN]) == tg, bar);
            __builtin_amdgcn_fence(__ATOMIC_ACQUIRE, "agent");
            xb_add(&bar[XB_XGEN(bx)], 1u);
            asm volatile("s_waitcnt vmcnt(0)" ::: "memory");
        } else {
            XB_SPIN(xb_ld(&bar[XB_XGEN(bx)]) == gen, bar);
            __builtin_amdgcn_fence(__ATOMIC_ACQUIRE, "agent");
            asm volatile("s_waitcnt vmcnt(0)" ::: "memory");
        }
    }
    __syncthreads();
}

constexpr int D = 2048, NTOK = 6144, NKEY = 7168, PW = 7280, INW = 15472, INWP = 15616, DFF = 5632;
constexpr int NT = 512;
constexpr int LDK = 2048 + 64, LDF = 5632 + 64, LDB = 512 + 64;
constexpr int GS = 8192 + 128;
constexpr float EPS = 1e-6f;
constexpr float ALPHA = 1.41421356237f;
constexpr int C_GDQ = 0, C_GDZ = 1536, C_GDB = 2048, C_GDA = 2056, C_GLQ = 2064, C_GLK = 2320, C_GLV = 2576,
              C_GLR = 3088, C_GLG = 3600, C_HGQ = 3632, C_HGF = 4144, C_HGI = 5168, C_HGG = 5680, C_MQA = 6192,
              C_MKV = 6704, C_MKP = 7216;
constexpr size_t O_Y = 0, O_SGDN = 12582912, O_SGLA = 16777216, O_SHG = 18874368, O_CKV = 23068672, O_KPE = 27262976;

constexpr size_t al(size_t x) { return (x + 255) & ~(size_t)255; }
constexpr size_t W_WINT = 0;
constexpr size_t W_WQT = W_WINT + al((size_t)2 * INWP * LDK * 2);
constexpr size_t W_WKVT = W_WQT + al((size_t)2 * 768 * 512 * 2);
constexpr size_t W_WBRT = W_WKVT + al((size_t)2 * 1024 * 512 * 2);
constexpr size_t W_WOUTT = W_WBRT + al((size_t)2 * 4 * 2048 * LDB * 2);
constexpr size_t W_W13T = W_WOUTT + al((size_t)2 * 2048 * LDK * 2);
constexpr size_t W_W2T = W_W13T + al((size_t)2 * 11264 * LDK * 2);
constexpr size_t W_MODP = W_W2T + al((size_t)2 * 2048 * LDF * 2);
constexpr size_t W_MOD = W_MODP + al((size_t)16 * 2 * 3 * 12288 * 4);
constexpr size_t W_CNT = W_MOD + al((size_t)2 * 3 * 12288 * 4);
constexpr size_t W_BAR = W_CNT + 256;
constexpr size_t W_XA = W_BAR + al((size_t)XCD_BAR_WORDS * 4);
constexpr size_t W_P = W_XA + al((size_t)NTOK * LDK * 2);
constexpr size_t W_ACT = W_P;
constexpr size_t W_V = W_P + al((size_t)NTOK * LDF * 2);
constexpr size_t W_X1 = W_V + al((size_t)NTOK * 2048 * 4);
constexpr size_t W_G = W_P + al((size_t)NTOK * PW * 4);
constexpr size_t W_OBUF = W_G + al((size_t)NTOK * GS * 2);
constexpr size_t W_SC = W_OBUF;
constexpr size_t W_PM = W_OBUF + al((size_t)6 * NTOK * 512 * 4);
constexpr size_t W_MERGED = W_PM;
constexpr size_t W_X2 = W_PM + al((size_t)33554432);
constexpr size_t W_GDQ = W_X2 + al((size_t)NTOK * 2048 * 4);
constexpr size_t W_GDK = W_GDQ + al((size_t)NTOK * 512 * 4);
constexpr size_t W_GDV = W_GDK + al((size_t)NTOK * 512 * 4);
constexpr size_t W_GDEG = W_GDV + al((size_t)NTOK * 512 * 4);
constexpr size_t W_GDBT = W_GDEG + al((size_t)2 * NTOK * 4 * 4);
constexpr size_t W_GDKQ = W_GDBT + al((size_t)2 * NTOK * 4 * 4);
constexpr size_t W_GLAA = W_GDKQ + al((size_t)NTOK * 4 * 4);
constexpr size_t W_HGA = W_GLAA + al((size_t)2 * NTOK * 256 * 4);
constexpr size_t W_HGK = W_HGA + al((size_t)2 * NTOK * 512 * 4);
constexpr size_t W_HGQ = W_HGK + al((size_t)2 * NTOK * 512 * 4);
constexpr size_t W_AQ = W_HGQ + al((size_t)NTOK * 512 * 4);
constexpr size_t W_KEYS = W_AQ + al((size_t)NTOK * 512 * 2);
constexpr size_t W_QM = W_KEYS + al((size_t)NKEY * 512 * 2);
constexpr size_t W_KM = W_QM + al((size_t)NTOK * 768 * 2);
constexpr size_t W_VT = W_KM + al((size_t)NKEY * 768 * 2);
constexpr size_t W_BR = W_VT + al((size_t)512 * NKEY * 2);
constexpr size_t W_END = W_BR + al((size_t)4 * NTOK * LDB * 2);
static_assert(W_X1 + (size_t)NTOK * 2048 * 4 <= W_G, "alias overflow");
static_assert((size_t)16777216 + 50331648 <= (size_t)6 * NTOK * 512 * 4, "scores alias overflow");
constexpr size_t LDS_BYTES = 131072 + 256;

struct Params {
  const float* in[35];
  float* out;
  char* ws;
};
enum { I_XP = 0, I_XS, I_C, I_SGDN, I_SGLA, I_SHG, I_CCKV, I_CKPE, I_CCTX, I_WADA, I_BADA, I_WIN, I_GCONV, I_GALOG,
       I_GDT, I_GNORM, I_GLW2, I_GLB, I_GLNORM, I_HGLB, I_HGNORM, I_QNORM, I_WQB, I_KVNORM, I_WKVB, I_WBR, I_BG,
       I_WOUT, I_LN1G, I_LN1B, I_LN2G, I_LN2B, I_W1, I_W3, I_W2 };

DEV int opaque(int x) { asm volatile("" : "+v"(x)); return x; }
DEV u16 f2bf(float f) { unsigned u = __float_as_uint(f); u += 0x7fffu + ((u >> 16) & 1u); return (u16)(u >> 16); }
DEV unsigned pk2(float a, float b) { return (unsigned)f2bf(a) | ((unsigned)f2bf(b) << 16); }
DEV float bf2f(u16 h) { return __uint_as_float(((unsigned)h) << 16); }
DEV f32x4 ld4b(const u16* p) {
  const u32x2 v = *(const u32x2*)p; f32x4 r;
  r.x = __uint_as_float(v.x << 16); r.y = __uint_as_float(v.x & 0xffff0000u); r.z = __uint_as_float(v.y << 16); r.w = __uint_as_float(v.y & 0xffff0000u);
  return r;
}
DEV f32x2 ld2b(const u16* p) {
  const unsigned v = *(const unsigned*)p; f32x2 r;
  r.x = __uint_as_float(v << 16); r.y = __uint_as_float(v & 0xffff0000u);
  return r;
}
DEV float sigm(float x) { return __builtin_amdgcn_rcpf(1.f + __expf(-x)); }
DEV float silu(float x) { return x * sigm(x); }
DEV float fsigm(float x) { return __builtin_amdgcn_rcpf(1.f + __expf(-x)); }
DEV float softplus(float x) { return x > 20.f ? x : log1pf(expf(x)); }
DEV int row_vidx(int row) { return row < 4096 ? 0 : 1 + ((row - 4096) >> 10); }
template <int CTRL, int RMASK> DEV float dpp0(float x) {
  return __builtin_bit_cast(float, __builtin_amdgcn_update_dpp(0, __builtin_bit_cast(int, x), CTRL, RMASK, 0xf, false));
}
DEV float wave_sum(float v) {
  v += dpp0<0x128, 0xf>(v); v += dpp0<0x124, 0xf>(v); v += dpp0<0x122, 0xf>(v); v += dpp0<0x121, 0xf>(v);
  v += dpp0<0x142, 0xa>(v); v += dpp0<0x143, 0xc>(v);
  return __builtin_bit_cast(float, __builtin_amdgcn_readlane(__builtin_bit_cast(int, v), 63));
}
DEV float wave_max(float v) {
#define WM_DPP(x, c) __builtin_bit_cast(float, __builtin_amdgcn_mov_dpp(__builtin_bit_cast(int, x), c, 0xf, 0xf, true))
  v = fmaxf(v, WM_DPP(v, 0x128)); v = fmaxf(v, WM_DPP(v, 0x124)); v = fmaxf(v, WM_DPP(v, 0x122)); v = fmaxf(v, WM_DPP(v, 0x121));
#undef WM_DPP
  const int vi = __builtin_bit_cast(int, v);
  const float a = __builtin_bit_cast(float, __builtin_amdgcn_readlane(vi, 0)), b = __builtin_bit_cast(float, __builtin_amdgcn_readlane(vi, 16));
  const float c = __builtin_bit_cast(float, __builtin_amdgcn_readlane(vi, 32)), d = __builtin_bit_cast(float, __builtin_amdgcn_readlane(vi, 48));
  return fmaxf(fmaxf(a, b), fmaxf(c, d));
}
DEV float q_sum(float v, float* red, int tid) {
  v = wave_sum(v); __syncthreads();
  if ((tid & 63) == 0) red[tid >> 6] = v;
  __syncthreads();
  const int w = (tid >> 6) & 4;
  return red[w] + red[w + 1] + red[w + 2] + red[w + 3];
}
DEV float block_sum(float v, float* red, int tid) {
  v = wave_sum(v); __syncthreads();
  if ((tid & 63) == 0) red[tid >> 6] = v;
  __syncthreads();
  return (red[0] + red[1]) + (red[2] + red[3]) + (red[4] + red[5]) + (red[6] + red[7]);
}
DEV float half_sum(float v, float* red, int tid) {
  v = wave_sum(v); __syncthreads();
  if ((tid & 63) == 0) red[tid >> 6] = v;
  __syncthreads();
  const int w = tid >> 6;
  return red[w & ~1] + red[w | 1];
}
DEV float row16_allsum(float x) {
  x += __builtin_bit_cast(float, __builtin_amdgcn_update_dpp(0, __builtin_bit_cast(int, x), 0x128, 0xf, 0xf, false));
  x += __builtin_bit_cast(float, __builtin_amdgcn_update_dpp(0, __builtin_bit_cast(int, x), 0x124, 0xf, 0xf, false));
  x += __builtin_bit_cast(float, __builtin_amdgcn_update_dpp(0, __builtin_bit_cast(int, x), 0x122, 0xf, 0xf, false));
  x += __builtin_bit_cast(float, __builtin_amdgcn_update_dpp(0, __builtin_bit_cast(int, x), 0x121, 0xf, 0xf, false));
  return x;
}

constexpr int LSTR = 72;
DEV void gemm_main(const u16* A, int lda, const u16* B, int ldb, int K, f32x16 (&acc)[2][2], u16* sA, u16* sB) {
  const int tid = opaque(threadIdx.x), lane = tid & 63, wave = tid >> 6, wm = wave >> 1, wn = wave & 1;
  const int lr = tid >> 3, lc = (tid & 7) * 8;
  const u16* ga = A + (size_t)lr * lda + lc;
  const u16* gb = B + (size_t)lr * ldb + lc;
  u32x4 ra[4], rb[2];
#pragma unroll
  for (int i = 0; i < 4; i++) ra[i] = *(const u32x4*)(ga + (size_t)(i * 64) * lda);
#pragma unroll
  for (int i = 0; i < 2; i++) rb[i] = *(const u32x4*)(gb + (size_t)(i * 64) * ldb);
  const int nk = K >> 6;
  const int aoff = (wm * 64 + (lane & 31)) * LSTR + (lane >> 5) * 8;
  const int boff = (wn * 64 + (lane & 31)) * LSTR + (lane >> 5) * 8;
  for (int kt = 0; kt < nk; kt++) {
    __syncthreads();
#pragma unroll
    for (int i = 0; i < 4; i++) *(u32x4*)(sA + (lr + i * 64) * LSTR + lc) = ra[i];
#pragma unroll
    for (int i = 0; i < 2; i++) *(u32x4*)(sB + (lr + i * 64) * LSTR + lc) = rb[i];
    __syncthreads();
    if (kt + 1 < nk) {
      const int k0 = (kt + 1) << 6;
#pragma unroll
      for (int i = 0; i < 4; i++) ra[i] = *(const u32x4*)(ga + (size_t)(i * 64) * lda + k0);
#pragma unroll
      for (int i = 0; i < 2; i++) rb[i] = *(const u32x4*)(gb + (size_t)(i * 64) * ldb + k0);
    }
#pragma unroll
    for (int kk = 0; kk < 4; kk++) {
      bf16x8 a0 = *(const bf16x8*)(sA + aoff + kk * 16);
      bf16x8 a1 = *(const bf16x8*)(sA + aoff + 32 * LSTR + kk * 16);
      bf16x8 b0 = *(const bf16x8*)(sB + boff + kk * 16);
      bf16x8 b1 = *(const bf16x8*)(sB + boff + 32 * LSTR + kk * 16);
      acc[0][0] = __builtin_amdgcn_mfma_f32_32x32x16_bf16(a0, b0, acc[0][0], 0, 0, 0);
      acc[0][1] = __builtin_amdgcn_mfma_f32_32x32x16_bf16(a0, b1, acc[0][1], 0, 0, 0);
      acc[1][0] = __builtin_amdgcn_mfma_f32_32x32x16_bf16(a1, b0, acc[1][0], 0, 0, 0);
      acc[1][1] = __builtin_amdgcn_mfma_f32_32x32x16_bf16(a1, b1, acc[1][1], 0, 0, 0);
    }
  }
}
DEV void zero_acc(f32x16 (&acc)[2][2]) {
#pragma unroll
  for (int i = 0; i < 2; i++)
#pragma unroll
    for (int j = 0; j < 2; j++)
#pragma unroll
      for (int r = 0; r < 16; r++) acc[i][j][r] = 0.f;
}
#define EPI_BEGIN                                                                         \
  const int tid_ = opaque(threadIdx.x); const int lane_ = tid_ & 63, wave_ = tid_ >> 6, wm_ = wave_ >> 1, wn_ = wave_ & 1; \
  _Pragma("unroll") for (int mi = 0; mi < 2; mi++) _Pragma("unroll") for (int ni = 0; ni < 2; ni++) \
  _Pragma("unroll") for (int r = 0; r < 16; r++) {                                        \
    const int row = m0 + wm_ * 64 + mi * 32 + (r & 3) + 8 * (r >> 2) + 4 * (lane_ >> 5);  \
    const int col = n0 + wn_ * 64 + ni * 32 + (lane_ & 31);                               \
    const float av = acc[mi][ni][r];
#define EPI_END }

struct EpiWin {
  static constexpr bool PERM = true, AFTER_DRAIN = false, KEEP = false;
  u16* P; u16* G; const float* bg;
  DEV void operator()(const f32x4 (&acc)[2][2][4][2], const pg8::Unit& u, int wr, int wc, int fr, int fq) const {
    const int pm = __builtin_amdgcn_readfirstlane(u.pm), pn = __builtin_amdgcn_readfirstlane(u.pn);
    const int row0 = pm * 256 + wr * 64 + fr, cu0 = pn * 256 + wc * 32;
#pragma unroll
    for (int bj = 0; bj < 2; ++bj) {
      const int col8 = cu0 + bj * 128 + 8 * fq;
      if (col8 < PW) {
        u16* pp = P + (size_t)row0 * PW + col8;
#pragma unroll
        for (int ai = 0; ai < 2; ++ai)
#pragma unroll
          for (int m = 0; m < 4; ++m) {
            const f32x4 v0 = acc[ai][bj][m][0], v1 = acc[ai][bj][m][1];
            u32x4 o; o.x = pk2(v0.x, v0.y); o.y = pk2(v0.z, v0.w); o.z = pk2(v1.x, v1.y); o.w = pk2(v1.z, v1.w);
            *(u32x4*)(pp + (size_t)(ai * 128 + m * 16) * PW) = o;
          }
      } else if (col8 < INW) {
        const int gc = col8 - PW;
        const f32x4 b0 = *(const f32x4*)(bg + gc), b1 = *(const f32x4*)(bg + gc + 4);
        u16* gp = G + (size_t)row0 * GS + gc;
#pragma unroll
        for (int ai = 0; ai < 2; ++ai)
#pragma unroll
          for (int m = 0; m < 4; ++m) {
            const f32x4 v0 = acc[ai][bj][m][0] + b0, v1 = acc[ai][bj][m][1] + b1;
            u32x4 o; o.x = pk2(fsigm(v0.x), fsigm(v0.y)); o.y = pk2(fsigm(v0.z), fsigm(v0.w)); o.z = pk2(fsigm(v1.x), fsigm(v1.y)); o.w = pk2(fsigm(v1.z), fsigm(v1.w));
            *(u32x4*)(gp + (size_t)(ai * 128 + m * 16) * GS) = o;
          }
      }
    }
  }
};
DEV f32x4 up4lo(u32x4 v) { f32x4 r; r.x = __uint_as_float(v.x << 16); r.y = __uint_as_float(v.x & 0xffff0000u); r.z = __uint_as_float(v.y << 16); r.w = __uint_as_float(v.y & 0xffff0000u); return r; }
DEV f32x4 up4hi(u32x4 v) { f32x4 r; r.x = __uint_as_float(v.z << 16); r.y = __uint_as_float(v.z & 0xffff0000u); r.z = __uint_as_float(v.w << 16); r.w = __uint_as_float(v.w & 0xffff0000u); return r; }
struct EpiRes {
  static constexpr bool PERM = true, AFTER_DRAIN = false, KEEP = false;
  u16* V; const u16* X; const float* gate;
  DEV void operator()(const f32x4 (&acc)[2][2][4][2], const pg8::Unit& u, int wr, int wc, int fr, int fq) const {
    const int pm = __builtin_amdgcn_readfirstlane(u.pm), pn = __builtin_amdgcn_readfirstlane(u.pn);
    const int row0 = pm * 256 + wr * 64 + fr, col0 = pn * 256 + wc * 32 + 8 * fq;
    const float* gp = gate + (size_t)row_vidx(pm * 256) * 12288 + col0;
    const u16* xp = X + (size_t)row0 * 2048 + col0;
    u16* vp = V + (size_t)row0 * 2048 + col0;
    f32x4 g[2][2];
#pragma unroll
    for (int bj = 0; bj < 2; ++bj)
#pragma unroll
      for (int n = 0; n < 2; ++n) g[bj][n] = *(const f32x4*)(gp + bj * 128 + n * 4);
#pragma unroll
    for (int ah = 0; ah < 4; ++ah) {
      const int ai = ah >> 1, mb = (ah & 1) * 2;
      u32x4 x[2][2];
#pragma unroll
      for (int mm = 0; mm < 2; ++mm)
#pragma unroll
        for (int bj = 0; bj < 2; ++bj) x[mm][bj] = *(const u32x4*)(xp + (size_t)(ai * 128 + (mb + mm) * 16) * 2048 + bj * 128);
#pragma unroll
      for (int mm = 0; mm < 2; ++mm)
#pragma unroll
        for (int bj = 0; bj < 2; ++bj) {
          const int m = mb + mm;
          const f32x4 v0 = up4lo(x[mm][bj]) * ALPHA + g[bj][0] * acc[ai][bj][m][0];
          const f32x4 v1 = up4hi(x[mm][bj]) * ALPHA + g[bj][1] * acc[ai][bj][m][1];
          u32x4 o; o.x = pk2(v0.x, v0.y); o.y = pk2(v0.z, v0.w); o.z = pk2(v1.x, v1.y); o.w = pk2(v1.z, v1.w);
          *(u32x4*)(vp + (size_t)(ai * 128 + m * 16) * 2048 + bj * 128) = o;
        }
    }
  }
};
struct EpiFfn1 {
  static constexpr bool PERM = true, AFTER_DRAIN = false, KEEP = false;
  u16* ACT;
  DEV void operator()(const f32x4 (&acc)[2][2][4][2], const pg8::Unit& u, int wr, int wc, int fr, int fq) const {
    const int pm = __builtin_amdgcn_readfirstlane(u.pm), pn = __builtin_amdgcn_readfirstlane(u.pn);
    const int row0 = pm * 256 + wr * 64 + fr, col0 = pn * 128 + wc * 32 + 8 * fq;
    u16* ap = ACT + (size_t)row0 * LDF + col0;
#pragma unroll
    for (int ai = 0; ai < 2; ++ai)
#pragma unroll
      for (int m = 0; m < 4; ++m) {
        const f32x4 a0 = acc[ai][0][m][0], a1 = acc[ai][0][m][1], b0 = acc[ai][1][m][0], b1 = acc[ai][1][m][1];
        u32x4 o;
        o.x = pk2(a0.x * fsigm(a0.x) * b0.x, a0.y * fsigm(a0.y) * b0.y);
        o.y = pk2(a0.z * fsigm(a0.z) * b0.z, a0.w * fsigm(a0.w) * b0.w);
        o.z = pk2(a1.x * fsigm(a1.x) * b1.x, a1.y * fsigm(a1.y) * b1.y);
        o.w = pk2(a1.z * fsigm(a1.z) * b1.z, a1.w * fsigm(a1.w) * b1.w);
        *(u32x4*)(ap + (size_t)(ai * 128 + m * 16) * LDF) = o;
      }
  }
};
struct BranchOrder {
  int c;
  DEV bool next(int i, pg8::Unit& u) const { if (c >= 192 || i >= 4) return false; u.pm = i * 24 + (c % 24); u.pn = i * 8 + (c / 24); return true; }
  DEV void a_ready(const pg8::Unit&) const {}
  DEV void done(const pg8::Unit&) const {}
};
struct EpiBranch {
  static constexpr bool PERM = true, AFTER_DRAIN = false, KEEP = true;
  u16* MERGED; const u16* G;
  DEV static f32x4 clampg(f32x4 g) { g.x = fmaxf(g.x, 1e-6f); g.y = fmaxf(g.y, 1e-6f); g.z = fmaxf(g.z, 1e-6f); g.w = fmaxf(g.w, 1e-6f); return g; }
  DEV static f32x4 ratio(f32x4 a, f32x4 b) { f32x4 r; r.x = a.x * __builtin_amdgcn_rcpf(b.x); r.y = a.y * __builtin_amdgcn_rcpf(b.y); r.z = a.z * __builtin_amdgcn_rcpf(b.z); r.w = a.w * __builtin_amdgcn_rcpf(b.w); return r; }
  DEV void operator()(f32x4 (&acc)[2][2][4][2], const pg8::Unit& u, int wr, int wc, int fr, int fq) const {
    const int upn = __builtin_amdgcn_readfirstlane(u.pn), upm = __builtin_amdgcn_readfirstlane(u.pm);
    const int k = upn >> 3, pn = upn & 7, pm = upm - k * 24;
    const int row0 = pm * 256 + wr * 64 + fr, col0 = pn * 256 + wc * 32 + 8 * fq;
    const u16* gbase = G + (size_t)row0 * GS + k * 2048 + col0;
    u16* obase = MERGED + (size_t)row0 * LDK + col0;
#pragma unroll
    for (int ah = 0; ah < 4; ++ah) {
      const int ai = ah >> 1, mb = (ah & 1) * 2;
      u32x4 r0[2][2], r1[2][2];
#pragma unroll
      for (int mm = 0; mm < 2; ++mm)
#pragma unroll
        for (int bj = 0; bj < 2; ++bj) {
          const u16* gp = gbase + (size_t)(ai * 128 + (mb + mm) * 16) * GS + bj * 128;
          r0[mm][bj] = *(const u32x4*)gp;
          if (k < 3) r1[mm][bj] = *(const u32x4*)(gp + 2048);
        }
#pragma unroll
      for (int mm = 0; mm < 2; ++mm)
#pragma unroll
        for (int bj = 0; bj < 2; ++bj) {
          const int m = mb + mm;
          const f32x4 g0l = clampg(up4lo(r0[mm][bj])), g0h = clampg(up4hi(r0[mm][bj]));
          if (k < 3) {
            const f32x4 g1l = clampg(up4lo(r1[mm][bj])), g1h = clampg(up4hi(r1[mm][bj]));
            acc[ai][bj][m][0] = acc[ai][bj][m][0] * ratio(g0l, g1l);
            acc[ai][bj][m][1] = acc[ai][bj][m][1] * ratio(g0h, g1h);
          } else {
            const f32x4 v0 = acc[ai][bj][m][0] * g0l, v1 = acc[ai][bj][m][1] * g0h;
            u32x4 o; o.x = pk2(v0.x, v0.y); o.y = pk2(v0.z, v0.w); o.z = pk2(v1.x, v1.y); o.w = pk2(v1.z, v1.w);
            *(u32x4*)(obase + (size_t)(ai * 128 + m * 16) * LDK + bj * 128) = o;
          }
        }
    }
  }
};

template <int MAP>
DEV void transpose_job(const float* __restrict__ W, int K, int N, u16* Wt, int ldt, float* sT, int tb, int tn, int t0 = 0, int t1 = 1 << 30) {
  const int tid = opaque(threadIdx.x);
  const int ktn = K >> 6, ntn = (N + 63) >> 6;
  const int tend = (ktn * ntn < t1) ? ktn * ntn : t1;
  for (int t = t0 + tb; t < tend; t += tn) {
    const int kt = t % ktn, nt = t / ktn;
    const int k0 = kt * 64, n0 = nt * 64;
    __syncthreads();
#pragma unroll
    for (int i = 0; i < 2; i++) {
      const int f = tid + i * NT, k = f >> 4, n4 = (f & 15) * 4;
      f32x4 v = {0.f, 0.f, 0.f, 0.f};
      if (n0 + n4 < N) v = *(const f32x4*)(W + (size_t)(k0 + k) * N + n0 + n4);
      sT[k * 65 + n4] = v.x; sT[k * 65 + n4 + 1] = v.y; sT[k * 65 + n4 + 2] = v.z; sT[k * 65 + n4 + 3] = v.w;
    }
    __syncthreads();
    {
      const int n = tid >> 3, kc = tid & 7;
      float v[8];
#pragma unroll
      for (int j = 0; j < 8; j++) v[j] = sT[(kc * 8 + j) * 65 + n];
      const int ng = n0 + n; int rr;
      if (MAP == 0) rr = ng;
      else if (MAP == 1) rr = (ng >> 7) * 256 + (ng & 127);
      else if (MAP == 2) rr = (ng >> 7) * 256 + 128 + (ng & 127);
      else { int h = ng >> 8, c = ng & 255; rr = (c < 128) ? (h * 128 + c) : (512 + h * 128 + (c - 128)); }
      u32x4 o; o.x = pk2(v[0], v[1]); o.y = pk2(v[2], v[3]); o.z = pk2(v[4], v[5]); o.w = pk2(v[6], v[7]);
      *(u32x4*)(Wt + (size_t)rr * ldt + k0 + kc * 8) = o;
    }
  }
}

template <int CTRL> DEV float dppmov(float x) { return __builtin_bit_cast(float, __builtin_amdgcn_mov_dpp(__builtin_bit_cast(int, x), CTRL, 0xf, 0xf, true)); }
template <int N> DEV void allsum_pairs(f32x2 (&v)[N]) {
#pragma unroll
  for (int i = 0; i < N; i++) { v[i].x += dppmov<0x128>(v[i].x); v[i].y += dppmov<0x128>(v[i].y); }
#pragma unroll
  for (int i = 0; i < N; i++) { v[i].x += dppmov<0x124>(v[i].x); v[i].y += dppmov<0x124>(v[i].y); }
#pragma unroll
  for (int i = 0; i < N; i++) { v[i].x += dppmov<0x122>(v[i].x); v[i].y += dppmov<0x122>(v[i].y); }
#pragma unroll
  for (int i = 0; i < N; i++) { v[i].x += dppmov<0x121>(v[i].x); v[i].y += dppmov<0x121>(v[i].y); }
}
template <int DK, int CC, bool HG = false>
DEV void rec_diag(const void* Apv, int lda, const u16* Kp, int ldk, const u16* Qp, int ldq, const u16* Vp, int ldv,
                  float* Op, float qscale, int L, int dir, const float* S0, float* Sout, float* lds, const float* lbp = nullptr) {
  constexpr int R = DK / 16, CW = 32 * CC, T = 16, NP = CC / 2;
  constexpr int NAT = T * DK / 4, NVT = T * CW / 4;
  const int tid = opaque(threadIdx.x), rg = tid & 15, cgi = tid >> 4;
  float* sA = lds; float* sK = sA + T * DK; float* sQ = sK + T * DK; float* sV = sQ + T * DK; float* sO = sV + T * CW;
  f32x2 S[R][NP];
#pragma unroll
  for (int r = 0; r < R; r++)
#pragma unroll
    for (int c = 0; c < NP; c++) {
      if (S0) S[r][c] = *(const f32x2*)(S0 + (size_t)(rg * R + r) * 128 + cgi * CC + 2 * c);
      else S[r][c] = (f32x2){0.f, 0.f};
    }
  f32x4 pa = {0, 0, 0, 0}, pk = {0, 0, 0, 0}, pq = {0, 0, 0, 0}, pv = {0, 0, 0, 0};
  const int sa_ = tid / (DK / 4), ca_ = (tid % (DK / 4)) * 4;
  const int sv_ = tid / (CW / 4), cv_ = (tid % (CW / 4)) * 4;
  const int nch = L / T;
  f32x4 lb4 = {0.f, 0.f, 0.f, 0.f};
  if (HG && lbp && tid < NAT) {
    const f32x4 l1 = *(const f32x4*)(lbp + 1024 + ca_), l0 = *(const f32x4*)(lbp + ca_);
    lb4.x = sigm(l1.x - l0.x); lb4.y = sigm(l1.y - l0.y); lb4.z = sigm(l1.z - l0.z); lb4.w = sigm(l1.w - l0.w);
  }
#define REC_LOAD(ch)                                                                              \
  {                                                                                               \
    if (tid < NAT) { int t = (ch) * T + sa_; if (dir) t = L - 1 - t;                              \
      if (HG) pa = ld4b((const u16*)Apv + (size_t)t * lda + ca_); else pa = *(const f32x4*)((const float*)Apv + (size_t)t * lda + ca_); \
      if (!HG) pk = ld4b(Kp + (size_t)t * ldk + ca_); \
      pq = ld4b(Qp + (size_t)t * ldq + ca_); }                                         \
    if (tid < NVT) { int t = (ch) * T + sv_; if (dir) t = L - 1 - t; pv = ld4b(Vp + (size_t)t * ldv + cv_); } \
  }
#define REC_FLUSH(ch)                                                                             \
  if (tid < NVT) { int t = (ch) * T + sv_; if (dir) t = L - 1 - t; *(f32x4*)(Op + (size_t)t * 512 + cv_) = ((const f32x4*)sO)[tid] * qscale; }
  REC_LOAD(0)
  for (int ch = 0; ch < nch; ch++) {
    __syncthreads();
    if (ch > 0) REC_FLUSH(ch - 1)
    if (HG) {
      if (tid < NAT) {
        f32x4 sg, sn, qq;
        sg.x = sigm(pa.x); sg.y = sigm(pa.y); sg.z = sigm(pa.z); sg.w = sigm(pa.w);
        sn.x = sigm(-pa.x); sn.y = sigm(-pa.y); sn.z = sigm(-pa.z); sn.w = sigm(-pa.w);
        qq.x = silu(pq.x); qq.y = silu(pq.y); qq.z = silu(pq.z); qq.w = silu(pq.w);
        const f32x4 oml = 1.f - lb4;
        ((f32x4*)sA)[tid] = lb4 + oml * sg; ((f32x4*)sK)[tid] = oml * sn; ((f32x4*)sQ)[tid] = qq;
      }
    } else
    if (tid < NAT) { ((f32x4*)sA)[tid] = pa; ((f32x4*)sK)[tid] = pk; ((f32x4*)sQ)[tid] = pq; }
    if (tid < NVT) ((f32x4*)sV)[tid] = pv;
    __syncthreads();
    if (ch + 1 < nch) REC_LOAD(ch + 1)
#pragma unroll 4
    for (int s = 0; s < T; s++) {
      float ar[R], kr[R], qr[R]; f32x2 vc[NP], os0[NP], os1[NP];
#pragma unroll
      for (int r4 = 0; r4 < R / 4; r4++) {
        f32x4 x = *(const f32x4*)(sA + s * DK + rg * R + r4 * 4);
        ar[r4 * 4] = x.x; ar[r4 * 4 + 1] = x.y; ar[r4 * 4 + 2] = x.z; ar[r4 * 4 + 3] = x.w;
        x = *(const f32x4*)(sK + s * DK + rg * R + r4 * 4);
        kr[r4 * 4] = x.x; kr[r4 * 4 + 1] = x.y; kr[r4 * 4 + 2] = x.z; kr[r4 * 4 + 3] = x.w;
        x = *(const f32x4*)(sQ + s * DK + rg * R + r4 * 4);
        qr[r4 * 4] = x.x; qr[r4 * 4 + 1] = x.y; qr[r4 * 4 + 2] = x.z; qr[r4 * 4 + 3] = x.w;
      }
#pragma unroll
      for (int c = 0; c < NP; c++) { vc[c] = *(const f32x2*)(sV + s * CW + cgi * CC + 2 * c); os0[c] = (f32x2){0.f, 0.f}; os1[c] = (f32x2){0.f, 0.f}; }
#pragma unroll
      for (int r = 0; r < R; r++)
#pragma unroll
        for (int c = 0; c < NP; c++) {
          f32x2 kv = vc[c] * kr[r];
          S[r][c] = __builtin_elementwise_fma((f32x2){ar[r], ar[r]}, S[r][c], kv);
          if (r & 1) os1[c] = __builtin_elementwise_fma((f32x2){qr[r], qr[r]}, S[r][c], os1[c]);
          else os0[c] = __builtin_elementwise_fma((f32x2){qr[r], qr[r]}, S[r][c], os0[c]);
        }
      f32x2 red[NP];
#pragma unroll
      for (int c = 0; c < NP; c++) red[c] = os0[c] + os1[c];
      allsum_pairs<NP>(red);
#pragma unroll
      for (int c = 0; c < NP; c++) *(f32x2*)(sO + s * CW + cgi * CC + 2 * c) = red[c];
    }
  }
  __syncthreads();
  REC_FLUSH(nch - 1)
#undef REC_LOAD
#undef REC_FLUSH
  if (Sout) {
#pragma unroll
    for (int r = 0; r < R; r++)
#pragma unroll
      for (int c = 0; c < NP; c++) *(f32x2*)(Sout + (size_t)(rg * R + r) * 128 + cgi * CC + 2 * c) = S[r][c];
  }
}

template <int CC>
DEV void rec_gdn(const float* Kp, const float* Qp, const float* Vp, const float* Egp, const float* Btp, const float* KQp,
                 float* Op, int L, int dir, const float* S0, float* Sout, float* lds) {
  constexpr int DK = 128, R = 8, CW = 32 * CC, T = 16, NP = CC / 2;
  constexpr int NVT = T * CW / 4;
  const int tid = opaque(threadIdx.x), rg = tid & 15, cgi = tid >> 4;
  float* sK = lds; float* sQ = sK + T * DK; float* sV = sQ + T * DK; float* sO = sV + T * CW; float* sE = sO + T * CW; float* sB = sE + T; float* sKQ = sB + T;
  f32x2 S[R][NP];
#pragma unroll
  for (int r = 0; r < R; r++)
#pragma unroll
    for (int c = 0; c < NP; c++) {
      if (S0) S[r][c] = *(const f32x2*)(S0 + (size_t)(rg * R + r) * 128 + cgi * CC + 2 * c);
      else S[r][c] = (f32x2){0.f, 0.f};
    }
  f32x4 pk = {0, 0, 0, 0}, pq = {0, 0, 0, 0}, pv = {0, 0, 0, 0};
  float pe = 0.f, pb = 0.f, pkq = 0.f;
  const int sa_ = tid >> 5, ca_ = (tid & 31) * 4;
  const int sv_ = tid / (CW / 4), cv_ = (tid % (CW / 4)) * 4;
  const int nch = L / T;
#define GDN_LOAD(ch)                                                                              \
  {                                                                                               \
    { int t = (ch) * T + sa_; if (dir) t = L - 1 - t;                                             \
      pk = *(const f32x4*)(Kp + (size_t)t * 512 + ca_); pq = *(const f32x4*)(Qp + (size_t)t * 512 + ca_); } \
    if (tid < NVT) { int t = (ch) * T + sv_; if (dir) t = L - 1 - t; pv = *(const f32x4*)(Vp + (size_t)t * 512 + cv_); } \
    if (tid < T) { int t = (ch) * T + tid; if (dir) t = L - 1 - t; pe = Egp[(size_t)t * 4]; pb = Btp[(size_t)t * 4]; pkq = KQp[(size_t)t * 4]; } \
  }
#define GDN_FLUSH(ch)                                                                             \
  if (tid < NVT) { int t = (ch) * T + sv_; if (dir) t = L - 1 - t; *(f32x4*)(Op + (size_t)t * 512 + cv_) = ((const f32x4*)sO)[tid]; }
  GDN_LOAD(0)
  for (int ch = 0; ch < nch; ch++) {
    __syncthreads();
    if (ch > 0) GDN_FLUSH(ch - 1)
    ((f32x4*)sK)[tid] = pk; ((f32x4*)sQ)[tid] = pq;
    if (tid < NVT) ((f32x4*)sV)[tid] = pv;
    if (tid < T) { sE[tid] = pe; sB[tid] = pb; sKQ[tid] = pkq; }
    __syncthreads();
    if (ch + 1 < nch) GDN_LOAD(ch + 1)
#pragma unroll 4
    for (int s = 0; s < T; s++) {
      float kr[R], qr[R]; f32x2 vc[NP], d0[NP], d1[NP], q0[NP], q1[NP];
#pragma unroll
      for (int r4 = 0; r4 < 2; r4++) {
        f32x4 x = *(const f32x4*)(sK + s * DK + rg * R + r4 * 4);
        kr[r4 * 4] = x.x; kr[r4 * 4 + 1] = x.y; kr[r4 * 4 + 2] = x.z; kr[r4 * 4 + 3] = x.w;
        x = *(const f32x4*)(sQ + s * DK + rg * R + r4 * 4);
        qr[r4 * 4] = x.x; qr[r4 * 4 + 1] = x.y; qr[r4 * 4 + 2] = x.z; qr[r4 * 4 + 3] = x.w;
      }
      const float e = sE[s], b = sB[s], kq = sKQ[s];
#pragma unroll
      for (int c = 0; c < NP; c++) {
        vc[c] = *(const f32x2*)(sV + s * CW + cgi * CC + 2 * c);
        d0[c] = (f32x2){0.f, 0.f}; d1[c] = (f32x2){0.f, 0.f}; q0[c] = (f32x2){0.f, 0.f}; q1[c] = (f32x2){0.f, 0.f};
      }
#pragma unroll
      for (int r = 0; r < R; r += 2)
#pragma unroll
        for (int c = 0; c < NP; c++) {
          d0[c] = __builtin_elementwise_fma((f32x2){kr[r], kr[r]}, S[r][c], d0[c]);
          q0[c] = __builtin_elementwise_fma((f32x2){qr[r], qr[r]}, S[r][c], q0[c]);
          d1[c] = __builtin_elementwise_fma((f32x2){kr[r + 1], kr[r + 1]}, S[r + 1][c], d1[c]);
          q1[c] = __builtin_elementwise_fma((f32x2){qr[r + 1], qr[r + 1]}, S[r + 1][c], q1[c]);
        }
      f32x2 red[2 * NP];
#pragma unroll
      for (int c = 0; c < NP; c++) { red[c] = d0[c] + d1[c]; red[NP + c] = q0[c] + q1[c]; }
      allsum_pairs<2 * NP>(red);
      f32x2 cc[NP];
#pragma unroll
      for (int c = 0; c < NP; c++) {
        cc[c] = (vc[c] - red[c] * e) * b;
        *(f32x2*)(sO + s * CW + cgi * CC + 2 * c) = red[NP + c] * e + cc[c] * kq;
      }
#pragma unroll
      for (int r = 0; r < R; r++)
#pragma unroll
        for (int c = 0; c < NP; c++) S[r][c] = __builtin_elementwise_fma((f32x2){e, e}, S[r][c], cc[c] * kr[r]);
    }
  }
  __syncthreads();
  GDN_FLUSH(nch - 1)
#undef GDN_LOAD
#undef GDN_FLUSH
  if (Sout) {
#pragma unroll
    for (int r = 0; r < R; r++)
#pragma unroll
      for (int c = 0; c < NP; c++) *(f32x2*)(Sout + (size_t)(rg * R + r) * 128 + cgi * CC + 2 * c) = S[r][c];
  }
}

DEV void rec_gdn8(const float* Kp, const float* Qp, const float* Vp, const float* Egp, const float* Btp, const float* KQp,
                  float* Op, int L, int dir, const float* S0, float* lds) {
  constexpr int DK = 128, R = 16, NPR = 8, CW = 64, T = 16;
  constexpr int NVT = T * CW / 4;
  const int tid = opaque(threadIdx.x), rg = tid & 7, cgi = tid >> 3;
  float* sK = lds; float* sQ = sK + T * DK; float* sV = sQ + T * DK; float* sO = sV + T * CW; float* sE = sO + T * CW; float* sB = sE + T; float* sKQ = sB + T;
  f32x2 S[NPR];
#pragma unroll
  for (int i = 0; i < NPR; i++) {
    S[i].x = S0[(size_t)(rg * R + 2 * i) * 128 + cgi];
    S[i].y = S0[(size_t)(rg * R + 2 * i + 1) * 128 + cgi];
  }
  f32x4 pk = {0, 0, 0, 0}, pq = {0, 0, 0, 0}, pv = {0, 0, 0, 0};
  float pe = 0.f, pb = 0.f, pkq = 0.f;
  const int sa_ = tid >> 5, ca_ = (tid & 31) * 4;
  const int sv_ = tid / (CW / 4), cv_ = (tid % (CW / 4)) * 4;
  const int nch = L / T;
#define GDN_LOAD(ch)                                                                              \
  {                                                                                               \
    { int t = (ch) * T + sa_; if (dir) t = L - 1 - t;                                             \
      pk = *(const f32x4*)(Kp + (size_t)t * 512 + ca_); pq = *(const f32x4*)(Qp + (size_t)t * 512 + ca_); } \
    if (tid < NVT) { int t = (ch) * T + sv_; if (dir) t = L - 1 - t; pv = *(const f32x4*)(Vp + (size_t)t * 512 + cv_); } \
    if (tid < T) { int t = (ch) * T + tid; if (dir) t = L - 1 - t; pe = Egp[(size_t)t * 4]; pb = Btp[(size_t)t * 4]; pkq = KQp[(size_t)t * 4]; } \
  }
#define GDN_FLUSH(ch)                                                                             \
  if (tid < NVT) { int t = (ch) * T + sv_; if (dir) t = L - 1 - t; *(f32x4*)(Op + (size_t)t * 512 + cv_) = ((const f32x4*)sO)[tid]; }
  GDN_LOAD(0)
  for (int ch = 0; ch < nch; ch++) {
    __syncthreads();
    if (ch > 0) GDN_FLUSH(ch - 1)
    ((f32x4*)sK)[tid] = pk; ((f32x4*)sQ)[tid] = pq;
    if (tid < NVT) ((f32x4*)sV)[tid] = pv;
    if (tid < T) { sE[tid] = pe; sB[tid] = pb; sKQ[tid] = pkq; }
    __syncthreads();
    if (ch + 1 < nch) GDN_LOAD(ch + 1)
#pragma unroll 4
    for (int s = 0; s < T; s++) {
      f32x2 k2[NPR], q2[NPR];
#pragma unroll
      for (int r4 = 0; r4 < 4; r4++) {
        f32x4 x = *(const f32x4*)(sK + s * DK + rg * R + r4 * 4);
        k2[2 * r4] = (f32x2){x.x, x.y}; k2[2 * r4 + 1] = (f32x2){x.z, x.w};
        x = *(const f32x4*)(sQ + s * DK + rg * R + r4 * 4);
        q2[2 * r4] = (f32x2){x.x, x.y}; q2[2 * r4 + 1] = (f32x2){x.z, x.w};
      }
      const float e = sE[s], b = sB[s], kq = sKQ[s], v = sV[s * CW + cgi];
      f32x2 d0 = k2[0] * S[0], d1 = k2[1] * S[1], g0 = q2[0] * S[0], g1 = q2[1] * S[1];
#pragma unroll
      for (int i = 2; i < NPR; i += 2) {
        d0 = __builtin_elementwise_fma(k2[i], S[i], d0); d1 = __builtin_elementwise_fma(k2[i + 1], S[i + 1], d1);
        g0 = __builtin_elementwise_fma(q2[i], S[i], g0); g1 = __builtin_elementwise_fma(q2[i + 1], S[i + 1], g1);
      }
      d0 = d0 + d1; g0 = g0 + g1;
      f32x2 red = {d0.x + d0.y, g0.x + g0.y};
      red.x += dppmov<0xB1>(red.x); red.y += dppmov<0xB1>(red.y);
      red.x += dppmov<0x4E>(red.x); red.y += dppmov<0x4E>(red.y);
      red.x += dppmov<0x141>(red.x); red.y += dppmov<0x141>(red.y);
      const float cc = b * (v - e * red.x);
      sO[s * CW + cgi] = e * red.y + kq * cc;
#pragma unroll
      for (int i = 0; i < NPR; i++) S[i] = __builtin_elementwise_fma((f32x2){e, e}, S[i], k2[i] * cc);
    }
  }
  __syncthreads();
  GDN_FLUSH(nch - 1)
#undef GDN_LOAD
#undef GDN_FLUSH
}

#define WINT ((u16*)(p.ws + W_WINT))
#define WQT ((u16*)(p.ws + W_WQT))
#define WKVT ((u16*)(p.ws + W_WKVT))
#define WBRT ((u16*)(p.ws + W_WBRT))
#define WOUTT ((u16*)(p.ws + W_WOUTT))
#define W13T ((u16*)(p.ws + W_W13T))
#define W2T ((u16*)(p.ws + W_W2T))
#define MODP ((float*)(p.ws + W_MODP))
#define MOD ((float*)(p.ws + W_MOD))
#define CNT ((int*)(p.ws + W_CNT))
#define XA ((u16*)(p.ws + W_XA))
#define P ((u16*)(p.ws + W_P))
#define ACT ((u16*)(p.ws + W_ACT))
#define V ((u16*)(p.ws + W_V))
#define X1 ((u16*)(p.ws + W_X1))
#define G ((u16*)(p.ws + W_G))
#define OBUF ((float*)(p.ws + W_OBUF))
#define SC ((float*)(p.ws + W_SC))
#define PM ((u16*)(p.ws + W_PM))
#define MERGED ((u16*)(p.ws + W_MERGED))
#define X2 ((u16*)(p.ws + W_X2))
#define GDQ ((float*)(p.ws + W_GDQ))
#define GDK ((float*)(p.ws + W_GDK))
#define GDV ((float*)(p.ws + W_GDV))
#define GDEG ((float*)(p.ws + W_GDEG))
#define GDBT ((float*)(p.ws + W_GDBT))
#define GDKQ ((float*)(p.ws + W_GDKQ))
#define GLAA ((float*)(p.ws + W_GLAA))
#define HGA ((float*)(p.ws + W_HGA))
#define HGK ((float*)(p.ws + W_HGK))
#define HGQ ((float*)(p.ws + W_HGQ))
#define AQ ((u16*)(p.ws + W_AQ))
#define KEYS ((u16*)(p.ws + W_KEYS))
#define QM ((u16*)(p.ws + W_QM))
#define KM ((u16*)(p.ws + W_KM))
#define VT ((u16*)(p.ws + W_VT))
#define BR ((u16*)(p.ws + W_BR))
__global__ void __launch_bounds__(512, 2) mega(Params p) {
  cg::grid_group grid = cg::this_grid();
  extern __shared__ __attribute__((aligned(16))) unsigned char smem[];
  float* red = (float*)(smem + 131072);
  int* s_item = (int*)(smem + 131072 + 128);
  u16* sA = (u16*)smem; u16* sB = sA + 256 * LSTR;
  float* sf = (float*)smem;
  const int tid0 = threadIdx.x;
  const int nb = gridDim.x, bid = blockIdx.x;
  if (tid0 < 4) ((volatile unsigned*)(smem + 131072 + 192))[tid0] = 0u;
  __syncthreads();
  const XcdBarrier xb = xcd_barrier_post((unsigned*)(p.ws + W_BAR), (volatile LAS unsigned*)(smem + 131072 + 192));
#define PHASE_TID const int tid = opaque(tid0); const int lane = tid & 63, wave = tid >> 6; (void)lane; (void)wave;
    REP_BEGIN(1)
  { PHASE_TID
  for (int l = 0; l < 2; l++) {
    const bool bg = (l == 1) && (nb > 192);
    transpose_job<0>(p.in[I_WIN] + (size_t)l * 2048 * INW, 2048, INW, WINT + (size_t)l * INWP * LDK, LDK, sf, bid, nb, bg ? 1920 : 0);
    if (l == 0 || nb <= 192) {
    transpose_job<1>(p.in[I_W1] + (size_t)l * 2048 * DFF, 2048, DFF, W13T + (size_t)l * 11264 * LDK, LDK, sf, bid, nb);
    transpose_job<2>(p.in[I_W3] + (size_t)l * 2048 * DFF, 2048, DFF, W13T + (size_t)l * 11264 * LDK, LDK, sf, bid, nb);
    transpose_job<0>(p.in[I_W2] + (size_t)l * DFF * 2048, DFF, 2048, W2T + (size_t)l * 2048 * LDF, LDF, sf, bid, nb);
    }
    if (!bg) {
    for (int k = 0; k < 4; k++)
      transpose_job<0>(p.in[I_WBR] + (size_t)(l * 4 + k) * 512 * 2048, 512, 2048, WBRT + (size_t)(l * 4 + k) * 2048 * LDB, LDB, sf, bid, nb);
    transpose_job<0>(p.in[I_WOUT] + (size_t)l * 2048 * 2048, 2048, 2048, WOUTT + (size_t)l * 2048 * LDK, LDK, sf, bid, nb);
    }
    transpose_job<0>(p.in[I_WQB] + (size_t)l * 512 * 768, 512, 768, WQT + (size_t)l * 768 * 512, 512, sf, bid, nb);
    transpose_job<3>(p.in[I_WKVB] + (size_t)l * 512 * 1024, 512, 1024, WKVT + (size_t)l * 1024 * 512, 512, sf, bid, nb);
  }
  for (int it = bid; it < 768; it += nb) {
    const int ks = it & 15, nbk = (it >> 4) % 24, l = it / (16 * 24);
    __syncthreads();
    if (tid < 128) {
      float c0 = p.in[I_CCTX][ks * 128 + tid], c1 = p.in[I_C][ks * 128 + tid], c2 = p.in[I_C][2048 + ks * 128 + tid];
      sf[tid] = silu(c0); sf[128 + tid] = silu(c1); sf[256 + tid] = silu(c2);
    }
    __syncthreads();
    const int n = nbk * 512 + tid;
    const float* w = p.in[I_WADA] + ((size_t)l * 2048 + ks * 128) * 12288 + n;
    float a0 = 0.f, a1 = 0.f, a2 = 0.f;
#pragma unroll 32
    for (int k = 0; k < 128; k++) {
      float wv = w[(size_t)k * 12288];
      a0 = fmaf(sf[k], wv, a0); a1 = fmaf(sf[128 + k], wv, a1); a2 = fmaf(sf[256 + k], wv, a2);
    }
    float* mp = MODP + (size_t)ks * (2 * 3 * 12288) + (size_t)l * 3 * 12288 + n;
    mp[0] = a0; mp[12288] = a1; mp[2 * 12288] = a2;
  }
  }
  grid.sync();
    REP_END
  { PHASE_TID
  for (int i = bid * NT + tid; i < 2 * 3 * 12288; i += nb * NT) {
    int l = i / (3 * 12288), n = i % 12288;
    float a = p.in[I_BADA][l * 12288 + n];
    for (int ks = 0; ks < 16; ks++) a += MODP[(size_t)ks * (2 * 3 * 12288) + i];
    MOD[i] = a;
  }
  }
  xcd_barrier(xb);
  { PHASE_TID
  for (int i = bid * NT + tid; i < NTOK * 512; i += nb * NT) {
    int row = i >> 9, c = (i & 511) * 4;
    const float* xp = row < 4096 ? p.in[I_XP] + (size_t)row * 2048 : p.in[I_XS] + (size_t)(row - 4096) * 2048;
    f32x4 x = *(const f32x4*)(xp + c);
    const float* md = MOD + (size_t)row_vidx(row) * 12288;
    f32x4 sh = *(const f32x4*)(md + c), sc = *(const f32x4*)(md + 2048 + c);
    u32x2 o;
    o.x = pk2(x.x * (1.f + sc.x) + sh.x, x.y * (1.f + sc.y) + sh.y);
    o.y = pk2(x.z * (1.f + sc.z) + sh.z, x.w * (1.f + sc.w) + sh.w);
    *(u32x2*)(XA + (size_t)row * LDK + c) = o;
    o.x = pk2(x.x, x.y); o.y = pk2(x.z, x.w);
    *(u32x2*)(X2 + (size_t)row * 2048 + c) = o;
  }
  }
  xcd_barrier(xb);

  for (int l = 0; l < 2; l++) {
    const float* modl = MOD + (size_t)l * 3 * 12288;
    REP_BEGIN(4)
    {
      pg8::Gemm g{XA, WINT + (size_t)l * INWP * LDK, NTOK, INWP, 2048, LDK, LDK};
      pg8::StaticOrder S; S.init(NTOK, INWP, nb, bid);
      EpiWin E{P, G, p.in[I_BG] + (size_t)l * 8192};
      pg8::gemm_phase<EpiWin, pg8::StaticOrder, false>((PG8_LAS unsigned char*)smem, g, S, E, nullptr);
    }
    xcd_barrier(xb);
    REP_END
    REP_BEGIN(2)
    { PHASE_TID
    const int gw = bid * 8 + wave, nw = nb * 8;
    for (int r = gw; r < NKEY; r += nw) {
      if (r >= NTOK) {
        const int e = r - NTOK, b = e >> 9, j = e & 511;
        const int keyrow = 4096 + b * 1536 + 1024 + j;
        const float* ck = p.in[I_CCKV] + ((size_t)(b * 2 + l) * 512 + j) * 512;
#pragma unroll
        for (int i = 0; i < 2; i++) {
          const int c = i * 256 + lane * 4;
          f32x4 v = *(const f32x4*)(ck + c);
          u32x2 o; o.x = pk2(v.x, v.y); o.y = pk2(v.z, v.w);
          *(u32x2*)(KEYS + (size_t)keyrow * 512 + c) = o;
        }
        const float kv = p.in[I_CKPE][((size_t)(b * 2 + l) * 512 + j) * 64 + lane];
        const u16 kb = f2bf(kv);
#pragma unroll
        for (int h = 0; h < 4; h++) KM[(size_t)keyrow * 768 + h * 192 + 128 + lane] = kb;
        continue;
      }
      const int row = r;
      const bool isctx = row < 4096;
      const int seq = isctx ? (row >> 8) : 16 + ((row - 4096) >> 10);
      const int t = isctx ? (row & 255) : ((row - 4096) & 1023);
      const int L = isctx ? 256 : 1024;
      const int keyrow = isctx ? row : 4096 + (seq - 16) * 1536 + t;
      const u16* Pr = P + (size_t)row * PW;
      {
        const float* cw = p.in[I_GCONV] + (size_t)l * 5 * 1536;
        auto conv2 = [&](int ch) -> f32x2 {
          f32x2 a = {0.f, 0.f};
#pragma unroll
          for (int k = 0; k < 5; k++) {
            const int tt = t + k - 2;
            if (tt >= 0 && tt < L) {
              const f32x2 x = ld2b(Pr + (ptrdiff_t)(k - 2) * PW + ch);
              const f32x2 w = *(const f32x2*)(cw + k * 1536 + ch);
              a = __builtin_elementwise_fma(x, w, a);
            }
          }
          a.x = silu(a.x); a.y = silu(a.y);
          return a;
        };
#pragma unroll 2
        for (int h = 0; h < 4; h++) {
          const int ch = h * 128 + lane * 2;
          f32x2 q = conv2(ch), k = conv2(512 + ch);
          const float sq = wave_sum(q.x * q.x + q.y * q.y), sk = wave_sum(k.x * k.x + k.y * k.y), qk = wave_sum(q.x * k.x + q.y * k.y);
          const float rq = rsqrtf(sq + EPS) * 0.08838834764831845f, rk = rsqrtf(sk + EPS);
          *(f32x2*)(GDQ + (size_t)row * 512 + ch) = q * rq;
          *(f32x2*)(GDK + (size_t)row * 512 + ch) = k * rk;
          if (lane == 0) GDKQ[(size_t)row * 4 + h] = qk * rq * rk;
        }
#pragma unroll 2
        for (int j = 0; j < 4; j++) {
          const int ch = j * 128 + lane * 2;
          *(f32x2*)(GDV + (size_t)row * 512 + ch) = conv2(1024 + ch);
        }
        if (lane < 8) {
          const int dir = lane >> 2, h = lane & 3;
          float bb = sigm(bf2f(Pr[C_GDB + lane]));
          float aa = bf2f(Pr[C_GDA + lane]);
          const float sx = aa + p.in[I_GDT][l * 8 + lane];
          const float sp_ = sx > 20.f ? sx : __logf(1.f + __expf(sx));
          float g = -__expf(p.in[I_GALOG][l * 8 + lane]) * sp_;
          GDEG[((size_t)dir * NTOK + row) * 4 + h] = __expf(g);
          GDBT[((size_t)dir * NTOK + row) * 4 + h] = bb;
        }
      }
      {
#pragma unroll
        for (int dir = 0; dir < 2; dir++) {
          const float* w2 = p.in[I_GLW2] + ((size_t)(l * 2 + dir) * 16) * 256 + lane * 4;
          f32x4 lg = *(const f32x4*)(p.in[I_GLB] + (l * 2 + dir) * 256 + lane * 4);
#pragma unroll
          for (int rr = 0; rr < 16; rr++) {
            const float gl = bf2f(Pr[C_GLG + dir * 16 + rr]);
            const f32x4 w = *(const f32x4*)(w2 + rr * 256);
            lg = lg + w * gl;
          }
          f32x4 o;
          o.x = __expf(__logf(sigm(lg.x)) * (1.f / 16.f));
          o.y = __expf(__logf(sigm(lg.y)) * (1.f / 16.f));
          o.z = __expf(__logf(sigm(lg.z)) * (1.f / 16.f));
          o.w = __expf(__logf(sigm(lg.w)) * (1.f / 16.f));
          *(f32x4*)(GLAA + ((size_t)dir * NTOK + row) * 256 + lane * 4) = o;
        }
      }
      {
        const f32x4 q0 = ld4b(Pr + C_MQA + lane * 4), q1 = ld4b(Pr + C_MQA + 256 + lane * 4);
        const f32x4 k0 = ld4b(Pr + C_MKV + lane * 4), k1 = ld4b(Pr + C_MKV + 256 + lane * 4);
        float ss = wave_sum(q0.x * q0.x + q0.y * q0.y + q0.z * q0.z + q0.w * q0.w + q1.x * q1.x + q1.y * q1.y + q1.z * q1.z + q1.w * q1.w);
        float rn = rsqrtf(ss * (1.f / 512.f) + EPS);
        const float* qn = p.in[I_QNORM] + l * 512;
        {
          const f32x4 n0 = *(const f32x4*)(qn + lane * 4), n1 = *(const f32x4*)(qn + 256 + lane * 4);
          const f32x4 a0 = q0 * rn * n0, a1 = q1 * rn * n1;
          u32x2 o; o.x = pk2(a0.x, a0.y); o.y = pk2(a0.z, a0.w);
          *(u32x2*)(AQ + (size_t)row * 512 + lane * 4) = o;
          o.x = pk2(a1.x, a1.y); o.y = pk2(a1.z, a1.w);
          *(u32x2*)(AQ + (size_t)row * 512 + 256 + lane * 4) = o;
        }
        ss = wave_sum(k0.x * k0.x + k0.y * k0.y + k0.z * k0.z + k0.w * k0.w + k1.x * k1.x + k1.y * k1.y + k1.z * k1.z + k1.w * k1.w);
        rn = rsqrtf(ss * (1.f / 512.f) + EPS);
        const float* kn = p.in[I_KVNORM] + l * 512;
        {
          const f32x4 n0 = *(const f32x4*)(kn + lane * 4), n1 = *(const f32x4*)(kn + 256 + lane * 4);
          const f32x4 c0 = k0 * rn * n0, c1 = k1 * rn * n1;
          u32x2 o; o.x = pk2(c0.x, c0.y); o.y = pk2(c0.z, c0.w);
          *(u32x2*)(KEYS + (size_t)keyrow * 512 + lane * 4) = o;
          o.x = pk2(c1.x, c1.y); o.y = pk2(c1.z, c1.w);
          *(u32x2*)(KEYS + (size_t)keyrow * 512 + 256 + lane * 4) = o;
          if (isctx) {
            float* oc = p.out + O_CKV + ((size_t)(seq * 2 + l) * 256 + t) * 512;
            *(f32x4*)(oc + lane * 4) = c0; *(f32x4*)(oc + 256 + lane * 4) = c1;
          }
        }
        {
          const int c = lane;
          float val;
          if (isctx) {
            val = bf2f(Pr[C_MKP + c]);
            p.out[O_KPE + ((size_t)(seq * 2 + l) * 256 + t) * 64 + c] = val;
          } else {
            const int hf = c >> 5, i = c & 15, second = (c >> 4) & 1;
            float x1 = bf2f(Pr[C_MKP + hf * 32 + i]), x2 = bf2f(Pr[C_MKP + hf * 32 + 16 + i]);
            float pos = hf ? (float)(t & 63) : (float)(t >> 6);
            float ang = pos * expf(-(float)i * (9.210340371976184f / 16.f));
            float sn, cs; sincosf(ang, &sn, &cs);
            val = second ? (x1 * sn + x2 * cs) : (x1 * cs - x2 * sn);
          }
          const u16 kb = f2bf(val);
#pragma unroll
          for (int h = 0; h < 4; h++) KM[(size_t)keyrow * 768 + h * 192 + 128 + c] = kb;
        }
      }
    }
    }
    xcd_barrier(xb);
    REP_END
    REP_BEGIN(6)
    { PHASE_TID
    for (int t = bid; t < 144 + 112 + 112; t += nb) {
      f32x16 acc[2][2]; zero_acc(acc);
      if (t < 144) {
        const int m0 = (t % 24) * 256, n0 = (t / 24) * 128;
        gemm_main(AQ + (size_t)m0 * 512, 512, WQT + (size_t)l * 768 * 512 + (size_t)n0 * 512, 512, 512, acc, sA, sB);
        const bool dec = m0 >= 4096;
        const int lane_ = lane, wm_ = wave >> 1, wn_ = wave & 1;
#pragma unroll
        for (int mi = 0; mi < 2; mi++)
#pragma unroll
          for (int ni = 0; ni < 2; ni++) {
            const int colbase = n0 + wn_ * 64 + ni * 32;
            const int c0 = colbase % 192;
            const bool pe = dec && (c0 >= 128);
#pragma unroll
            for (int r = 0; r < 16; r++) {
              const int row = m0 + wm_ * 64 + mi * 32 + (r & 3) + 8 * (r >> 2) + 4 * (lane_ >> 5);
              const int col = colbase + (lane_ & 31);
              float av = acc[mi][ni][r];
              if (pe) {
                float other = __shfl_xor(av, 16);
                const int tt = (row - 4096) & 1023;
                const int i = lane_ & 15, second = (lane_ >> 4) & 1;
                float pos = (c0 >= 160) ? (float)(tt & 63) : (float)(tt >> 6);
                float ang = pos * expf(-(float)i * (9.210340371976184f / 16.f));
                float sn, cs; sincosf(ang, &sn, &cs);
                av = second ? (other * sn + av * cs) : (av * cs - other * sn);
              }
              QM[(size_t)row * 768 + col] = f2bf(av);
            }
          }
      } else if (t < 256) {
        const int tt = t - 144;
        const int m0 = (tt % 28) * 256, n0 = (tt / 28) * 128;
        gemm_main(KEYS + (size_t)m0 * 512, 512, WKVT + (size_t)l * 1024 * 512 + (size_t)n0 * 512, 512, 512, acc, sA, sB);
        EPI_BEGIN
          KM[(size_t)row * 768 + (col >> 7) * 192 + (col & 127)] = f2bf(av);
        EPI_END
      } else {
        const int tt = t - 256;
        const int m0 = (tt & 1) * 256, n0 = (tt >> 1) * 128;
        gemm_main(WKVT + (size_t)l * 1024 * 512 + (size_t)(512 + m0) * 512, 512, KEYS + (size_t)n0 * 512, 512, 512, acc, sA, sB);
        EPI_BEGIN
          VT[(size_t)row * NKEY + col] = f2bf(av);
        EPI_END
      }
    }
    }
    xcd_barrier(xb);
    REP_END
    REP_BEGIN(6)
    { PHASE_TID
    for (int t = bid; t < 128 + 384; t += nb) {
      f32x16 acc[2][2]; zero_acc(acc);
      int m0, n0; const u16 *Ap, *Bp; float* Cp; int ldc;
      if (t < 128) {
        const int sh = t >> 1, seq = sh >> 2, h = sh & 3;
        m0 = 0; n0 = (t & 1) * 128;
        Ap = QM + (size_t)(seq * 256) * 768 + h * 192; Bp = KM + (size_t)(seq * 256) * 768 + h * 192;
        Cp = SC + (size_t)sh * 256 * 256; ldc = 256;
      } else {
        const int tt = t - 128, bh = tt / 48, rem = tt % 48, b = bh >> 2, h = bh & 3;
        m0 = (rem / 12) * 256; n0 = (rem % 12) * 128;
        Ap = QM + (size_t)(4096 + b * 1024) * 768 + h * 192; Bp = KM + (size_t)(4096 + b * 1536) * 768 + h * 192;
        Cp = SC + (size_t)4194304 + (size_t)bh * 1024 * 1536; ldc = 1536;
      }
      gemm_main(Ap + (size_t)m0 * 768, 768, Bp + (size_t)n0 * 768, 768, 192, acc, sA, sB);
      EPI_BEGIN
        Cp[(size_t)row * ldc + col] = av;
      EPI_END
    }
    }
    xcd_barrier(xb);
    REP_END
    REP_BEGIN(6)
    { PHASE_TID
      const float scale = 0.07216878364870323f;
      const int gw = bid * 8 + wave, nw = nb * 8;
      for (int r = gw; r < 16384; r += nw) {
        f32x4 v = *(const f32x4*)(SC + (size_t)r * 256 + lane * 4);
        float m = wave_max(fmaxf(fmaxf(v.x, v.y), fmaxf(v.z, v.w)));
        v.x = __expf((v.x - m) * scale); v.y = __expf((v.y - m) * scale);
        v.z = __expf((v.z - m) * scale); v.w = __expf((v.w - m) * scale);
        float inv = 1.f / wave_sum(v.x + v.y + v.z + v.w);
        u32x2 o; o.x = pk2(v.x * inv, v.y * inv); o.y = pk2(v.z * inv, v.w * inv);
        *(u32x2*)(PM + (size_t)r * 256 + lane * 4) = o;
      }
      for (int r = gw; r < 8192; r += nw) {
        const float* sp = SC + (size_t)4194304 + (size_t)r * 1536;
        u16* pp = PM + (size_t)4194304 + (size_t)r * 1536;
        f32x4 v[6];
        float m = -3.0e38f;
#pragma unroll
        for (int j = 0; j < 6; j++) {
          v[j] = *(const f32x4*)(sp + j * 256 + lane * 4);
          m = fmaxf(m, fmaxf(fmaxf(v[j].x, v[j].y), fmaxf(v[j].z, v[j].w)));
        }
        m = wave_max(m);
        float s = 0.f;
#pragma unroll
        for (int j = 0; j < 6; j++) {
          v[j].x = __expf((v[j].x - m) * scale); v[j].y = __expf((v[j].y - m) * scale);
          v[j].z = __expf((v[j].z - m) * scale); v[j].w = __expf((v[j].w - m) * scale);
          s += v[j].x + v[j].y + v[j].z + v[j].w;
        }
        float inv = 1.f / wave_sum(s);
#pragma unroll
        for (int j = 0; j < 6; j++) {
          u32x2 o; o.x = pk2(v[j].x * inv, v[j].y * inv); o.y = pk2(v[j].z * inv, v[j].w * inv);
          *(u32x2*)(pp + j * 256 + lane * 4) = o;
        }
      }
    }
    xcd_barrier(xb);
    REP_END
    REP_BEGIN(3)
    { PHASE_TID
    for (int t = bid; t < 64 + 32; t += nb) {
      f32x16 acc[2][2]; zero_acc(acc);
      int m0, K, rowbase, h; const u16 *Ap, *Bp;
      if (t < 64) {
        const int sh = t, seq = sh >> 2; h = sh & 3;
        m0 = 0; K = 256; rowbase = seq * 256;
        Ap = PM + (size_t)sh * 256 * 256; Bp = VT + (size_t)(h * 128) * NKEY + seq * 256;
      } else {
        const int tt = t - 64, bh = tt >> 2, b = bh >> 2; h = bh & 3;
        m0 = (tt & 3) * 256; K = 1536; rowbase = 4096 + b * 1024;
        Ap = PM + (size_t)4194304 + (size_t)bh * 1024 * 1536; Bp = VT + (size_t)(h * 128) * NKEY + 4096 + b * 1536;
      }
      gemm_main(Ap + (size_t)m0 * K, K, Bp, NKEY, K, acc, sA, sB);
      const int n0 = 0;
      EPI_BEGIN
        BR[((size_t)3 * NTOK + rowbase + row) * LDB + h * 128 + col] = f2bf(av);
      EPI_END
    }
    }
    { PHASE_TID
    for (;;) {
      __syncthreads();
      if (tid == 0) *s_item = atomicAdd(&CNT[l + 2 * rep_], 1);
      __syncthreads();
      const int it = *s_item;
      if (it >= 480) break;
      int br, seq, h, dir, cb, isc;
      if (it < 96) { br = it >> 5; const int u = (it & 31) >> 1; cb = it & 1; seq = 16 + (u >> 3); h = (u >> 1) & 3; dir = u & 1; isc = 0; }
      else { const int j = it - 96; br = j >> 7; const int u = j & 127; cb = 0; seq = u >> 3; h = (u >> 1) & 3; dir = u & 1; isc = 1; }
      const int row0 = seq < 16 ? seq * 256 : 4096 + (seq - 16) * 1024;
      const int L = seq < 16 ? 256 : 1024;
      const int colbase = cb * 64;
      if (br == 0) {
        const float* S0 = nullptr; float* So = nullptr;
        if (seq >= 16) S0 = p.in[I_SGDN] + ((((size_t)(seq - 16) * 2 + l) * 2 + dir) * 4 + h) * 16384 + colbase;
        else So = p.out + O_SGDN + ((((size_t)seq * 2 + l) * 2 + dir) * 4 + h) * 16384;
        const float* Kp = GDK + (size_t)row0 * 512 + h * 128; const float* Qp = GDQ + (size_t)row0 * 512 + h * 128;
        const float* Vp = GDV + (size_t)row0 * 512 + h * 128 + colbase;
        const float* Eg = GDEG + ((size_t)dir * NTOK + row0) * 4 + h; const float* Bt = GDBT + ((size_t)dir * NTOK + row0) * 4 + h;
        float* Op = OBUF + ((size_t)(0 * 2 + dir) * NTOK + row0) * 512 + h * 128 + colbase;
        const float* KQ = GDKQ + (size_t)row0 * 4 + h;
        if (isc) rec_gdn<4>(Kp, Qp, Vp, Eg, Bt, KQ, Op, L, dir, S0, So, sf);
        else rec_gdn8(Kp, Qp, Vp, Eg, Bt, KQ, Op, L, dir, S0, sf);
      } else if (br == 1) {
        const float* S0 = nullptr; float* So = nullptr;
        if (seq >= 16) S0 = p.in[I_SHG] + ((((size_t)(seq - 16) * 2 + l) * 2 + dir) * 4 + h) * 16384 + colbase;
        else So = p.out + O_SHG + ((((size_t)seq * 2 + l) * 2 + dir) * 4 + h) * 16384;
        const u16* Ap = P + (size_t)row0 * PW + C_HGF + dir * 512 + h * 128; const u16* Kp = Ap;
        const u16* Qp = P + (size_t)row0 * PW + C_HGQ + h * 128;
        const float* lbp = (l == 1) ? p.in[I_HGLB] + dir * 512 + h * 128 : nullptr;
        const u16* Vp = P + (size_t)row0 * PW + C_HGI + h * 128 + colbase;
        float* Op = OBUF + ((size_t)(2 * 2 + dir) * NTOK + row0) * 512 + h * 128 + colbase;
        if (isc) rec_diag<128, 4, true>(Ap, PW, Kp, PW, Qp, PW, Vp, PW, Op, 1.f, L, dir, S0, So, sf, lbp);
        else rec_diag<128, 2, true>(Ap, PW, Kp, PW, Qp, PW, Vp, PW, Op, 1.f, L, dir, S0, So, sf, lbp);
      } else {
        const float* S0 = nullptr; float* So = nullptr;
        if (seq >= 16) S0 = p.in[I_SGLA] + ((((size_t)(seq - 16) * 2 + l) * 2 + dir) * 4 + h) * 8192 + colbase;
        else So = p.out + O_SGLA + ((((size_t)seq * 2 + l) * 2 + dir) * 4 + h) * 8192;
        const float* Ap = GLAA + ((size_t)dir * NTOK + row0) * 256 + h * 64;
        const u16* Kp = P + (size_t)row0 * PW + C_GLK + h * 64; const u16* Qp = P + (size_t)row0 * PW + C_GLQ + h * 64;
        const u16* Vp = P + (size_t)row0 * PW + C_GLV + h * 128 + colbase;
        float* Op = OBUF + ((size_t)(1 * 2 + dir) * NTOK + row0) * 512 + h * 128 + colbase;
        if (isc) rec_diag<64, 4>(Ap, 256, Kp, PW, Qp, PW, Vp, PW, Op, 0.125f, L, dir, S0, So, sf);
        else rec_diag<64, 2>(Ap, 256, Kp, PW, Qp, PW, Vp, PW, Op, 0.125f, L, dir, S0, So, sf);
      }
    }
    }
    xcd_barrier(xb);
    REP_END
    REP_BEGIN(7)
    { PHASE_TID
    const int gw = bid * 8 + wave, nw = nb * 8;
    for (int row = gw; row < NTOK; row += nw) {
      const u16* Pr = P + (size_t)row * PW;
      const int c8 = lane * 8, d8 = (lane & 15) * 8;
#pragma unroll
      for (int br = 0; br < 3; br++) {
        const float* nw_ = (br == 0 ? p.in[I_GNORM] : br == 1 ? p.in[I_GLNORM] : p.in[I_HGNORM]) + l * 128 + d8;
        const int gofs = br == 0 ? C_GDZ : br == 1 ? C_GLR : C_HGG;
        const float* of = OBUF + ((size_t)(br * 2 + 0) * NTOK + row) * 512 + c8;
        const float* ob = OBUF + ((size_t)(br * 2 + 1) * NTOK + row) * 512 + c8;
        const f32x4 o0 = *(const f32x4*)of + *(const f32x4*)ob, o1 = *(const f32x4*)(of + 4) + *(const f32x4*)(ob + 4);
        const u32x4 graw = *(const u32x4*)(Pr + gofs + c8);
        const f32x4 w0 = *(const f32x4*)nw_, w1 = *(const f32x4*)(nw_ + 4);
        float ss = (o0.x * o0.x + o0.y * o0.y) + (o0.z * o0.z + o0.w * o0.w) + (o1.x * o1.x + o1.y * o1.y) + (o1.z * o1.z + o1.w * o1.w);
        ss += dppmov<0x128>(ss); ss += dppmov<0x124>(ss); ss += dppmov<0x122>(ss); ss += dppmov<0x121>(ss);
        const float rn = rsqrtf(ss * (1.f / 128.f) + EPS);
        const f32x4 g0 = up4lo(graw), g1 = up4hi(graw);
        f32x4 t0, t1;
        if (br == 2) {
          t0.x = sigm(g0.x); t0.y = sigm(g0.y); t0.z = sigm(g0.z); t0.w = sigm(g0.w);
          t1.x = sigm(g1.x); t1.y = sigm(g1.y); t1.z = sigm(g1.z); t1.w = sigm(g1.w);
        } else {
          t0.x = silu(g0.x); t0.y = silu(g0.y); t0.z = silu(g0.z); t0.w = silu(g0.w);
          t1.x = silu(g1.x); t1.y = silu(g1.y); t1.z = silu(g1.z); t1.w = silu(g1.w);
        }
        const f32x4 r0 = o0 * rn * w0 * t0, r1 = o1 * rn * w1 * t1;
        u32x4 o; o.x = pk2(r0.x, r0.y); o.y = pk2(r0.z, r0.w); o.z = pk2(r1.x, r1.y); o.w = pk2(r1.z, r1.w);
        *(u32x4*)(BR + ((size_t)br * NTOK + row) * LDB + c8) = o;
      }
    }
    }
    xcd_barrier(xb);
    REP_END
    REP_BEGIN(5)
    {
      pg8::Gemm g{BR, WBRT + (size_t)l * 4 * 2048 * LDB, 4 * NTOK, 4 * 2048, 512, LDB, LDB};
      BranchOrder S{bid};
      EpiBranch E{MERGED, G};
      pg8::gemm_phase<EpiBranch, BranchOrder, false>((PG8_LAS unsigned char*)smem, g, S, E, nullptr);
      if (l == 0 && nb > 192 && bid >= 192) {
        transpose_job<1>(p.in[I_W1] + (size_t)2048 * DFF, 2048, DFF, W13T + (size_t)11264 * LDK, LDK, sf, bid - 192, nb - 192);
        transpose_job<2>(p.in[I_W3] + (size_t)2048 * DFF, 2048, DFF, W13T + (size_t)11264 * LDK, LDK, sf, bid - 192, nb - 192);
      }
    }
    xcd_barrier(xb);
    REP_END
    REP_BEGIN(4)
    {
      pg8::Gemm g{MERGED, WOUTT + (size_t)l * 2048 * LDK, NTOK, 2048, 2048, LDK, LDK};
      pg8::StaticOrder S; S.init(NTOK, 2048, nb, bid);
      EpiRes E{V, X2, modl + 4096};
      pg8::gemm_phase<EpiRes, pg8::StaticOrder, false>((PG8_LAS unsigned char*)smem, g, S, E, nullptr);
      if (l == 0 && nb > 192 && bid >= 192) {
        for (int k = 0; k < 4; k++)
          transpose_job<0>(p.in[I_WBR] + (size_t)(4 + k) * 512 * 2048, 512, 2048, WBRT + (size_t)(4 + k) * 2048 * LDB, LDB, sf, bid - 192, nb - 192);
        transpose_job<0>(p.in[I_WOUT] + (size_t)2048 * 2048, 2048, 2048, WOUTT + (size_t)2048 * LDK, LDK, sf, bid - 192, nb - 192);
      }
    }
    xcd_barrier(xb);
    REP_END
    REP_BEGIN(7)
    { PHASE_TID
    const int gw = bid * 8 + wave, nw = nb * 8;
    for (int row = gw; row < NTOK; row += nw) {
      const u16* vr = V + (size_t)row * 2048;
      f32x4 x[8]; float s1 = 0.f;
#pragma unroll
      for (int jj = 0; jj < 4; jj++) { const u32x4 raw = *(const u32x4*)(vr + jj * 512 + lane * 8); x[2 * jj] = up4lo(raw); x[2 * jj + 1] = up4hi(raw); }
#pragma unroll
      for (int j = 0; j < 8; j++) s1 += (x[j].x + x[j].y) + (x[j].z + x[j].w);
      const float mu = wave_sum(s1) * (1.f / 2048.f);
      float s2 = 0.f;
#pragma unroll
      for (int j = 0; j < 8; j++) { x[j] = x[j] - mu; s2 += (x[j].x * x[j].x + x[j].y * x[j].y) + (x[j].z * x[j].z + x[j].w * x[j].w); }
      const float rn = rsqrtf(wave_sum(s2) * (1.f / 2048.f) + EPS);
      const float* md = modl + (size_t)row_vidx(row) * 12288 + 6144;
#pragma unroll
      for (int jj = 0; jj < 4; jj++) {
        const int c = jj * 512 + lane * 8;
        f32x4 y[2]; u32x4 oy, oa;
#pragma unroll
        for (int hh = 0; hh < 2; hh++) {
          const int cc = c + hh * 4;
          const f32x4 gg = *(const f32x4*)(p.in[I_LN1G] + l * 2048 + cc), bb = *(const f32x4*)(p.in[I_LN1B] + l * 2048 + cc);
          y[hh] = x[2 * jj + hh] * rn * gg + bb;
          const f32x4 sh = *(const f32x4*)(md + cc), sc = *(const f32x4*)(md + 2048 + cc);
          const unsigned a0 = pk2(y[hh].x * (1.f + sc.x) + sh.x, y[hh].y * (1.f + sc.y) + sh.y), a1 = pk2(y[hh].z * (1.f + sc.z) + sh.z, y[hh].w * (1.f + sc.w) + sh.w);
          const unsigned y0 = pk2(y[hh].x, y[hh].y), y1 = pk2(y[hh].z, y[hh].w);
          if (hh == 0) { oy.x = y0; oy.y = y1; oa.x = a0; oa.y = a1; } else { oy.z = y0; oy.w = y1; oa.z = a0; oa.w = a1; }
        }
        *(u32x4*)(X1 + (size_t)row * 2048 + c) = oy;
        *(u32x4*)(XA + (size_t)row * LDK + c) = oa;
      }
    }
    }
    xcd_barrier(xb);
    REP_END
    REP_BEGIN(4)
    {
      pg8::Gemm g{XA, W13T + (size_t)l * 11264 * LDK, NTOK, 11264, 2048, LDK, LDK};
      pg8::StaticOrder S; S.init(NTOK, 11264, nb, bid);
      EpiFfn1 E{ACT};
      pg8::gemm_phase<EpiFfn1, pg8::StaticOrder, false>((PG8_LAS unsigned char*)smem, g, S, E, nullptr);
    }
    xcd_barrier(xb);
    REP_END
    REP_BEGIN(4)
    {
      pg8::Gemm g{ACT, W2T + (size_t)l * 2048 * LDF, NTOK, 2048, DFF, LDF, LDF};
      pg8::StaticOrder S; S.init(NTOK, 2048, nb, bid);
      EpiRes E{V, X1, modl + 10240};
      pg8::gemm_phase<EpiRes, pg8::StaticOrder, false>((PG8_LAS unsigned char*)smem, g, S, E, nullptr);
      if (l == 0 && nb > 192 && bid >= 192) {
        transpose_job<0>(p.in[I_W2] + (size_t)DFF * 2048, DFF, 2048, W2T + (size_t)2048 * LDF, LDF, sf, bid - 192, nb - 192);
        transpose_job<0>(p.in[I_WIN] + (size_t)2048 * INW, 2048, INW, WINT + (size_t)INWP * LDK, LDK, sf, bid - 192, nb - 192, 0, 1920);
      }
    }
    xcd_barrier(xb);
    REP_END

    { PHASE_TID
    const int gw = bid * 8 + wave, nw = nb * 8;
    for (int row = gw; row < NTOK; row += nw) {
      const u16* vr = V + (size_t)row * 2048;
      f32x4 x[8]; float s1 = 0.f;
#pragma unroll
      for (int jj = 0; jj < 4; jj++) { const u32x4 raw = *(const u32x4*)(vr + jj * 512 + lane * 8); x[2 * jj] = up4lo(raw); x[2 * jj + 1] = up4hi(raw); }
#pragma unroll
      for (int j = 0; j < 8; j++) s1 += (x[j].x + x[j].y) + (x[j].z + x[j].w);
      const float mu = wave_sum(s1) * (1.f / 2048.f);
      float s2 = 0.f;
#pragma unroll
      for (int j = 0; j < 8; j++) { x[j] = x[j] - mu; s2 += (x[j].x * x[j].x + x[j].y * x[j].y) + (x[j].z * x[j].z + x[j].w * x[j].w); }
      const float rn = rsqrtf(wave_sum(s2) * (1.f / 2048.f) + EPS);
      const float* md = MOD + (size_t)(3 + row_vidx(row)) * 12288;
#pragma unroll
      for (int jj = 0; jj < 4; jj++) {
        const int c = jj * 512 + lane * 8;
        u32x4 oy, oa;
#pragma unroll
        for (int hh = 0; hh < 2; hh++) {
          const int cc = c + hh * 4;
          const f32x4 gg = *(const f32x4*)(p.in[I_LN2G] + l * 2048 + cc), bb = *(const f32x4*)(p.in[I_LN2B] + l * 2048 + cc);
          const f32x4 y = x[2 * jj + hh] * rn * gg + bb;
          if (l == 1) *(f32x4*)(p.out + O_Y + (size_t)row * 2048 + cc) = y;
          else {
            const f32x4 sh = *(const f32x4*)(md + cc), sc = *(const f32x4*)(md + 2048 + cc);
            const unsigned a0 = pk2(y.x * (1.f + sc.x) + sh.x, y.y * (1.f + sc.y) + sh.y), a1 = pk2(y.z * (1.f + sc.z) + sh.z, y.w * (1.f + sc.w) + sh.w);
            const unsigned y0 = pk2(y.x, y.y), y1 = pk2(y.z, y.w);
            if (hh == 0) { oy.x = y0; oy.y = y1; oa.x = a0; oa.y = a1; } else { oy.z = y0; oy.w = y1; oa.z = a0; oa.w = a1; }
          }
        }
        if (l == 0) {
          *(u32x4*)(X2 + (size_t)row * 2048 + c) = oy;
          *(u32x4*)(XA + (size_t)row * LDK + c) = oa;
        }
      }
    }
    }
    if (l == 0) xcd_barrier(xb);
  }
}

extern "C" void kernel_launch(void* const* d_in, const int* in_sizes, int n_in, void* d_out, int out_size, void* d_ws,
                              size_t ws_size, hipStream_t stream) {
  if (ws_size < W_END) { fprintf(stderr, "workspace too small: %zu < %zu\n", ws_size, (size_t)W_END); return; }
  static int grid_blocks = 0;
  if (!grid_blocks) {
    int dev = 0, cus = 0, per_cu = 0;
    (void)hipGetDevice(&dev);
    (void)hipDeviceGetAttribute(&cus, hipDeviceAttributeMultiprocessorCount, dev);
    (void)hipFuncSetAttribute((const void*)mega, hipFuncAttributeMaxDynamicSharedMemorySize, (int)LDS_BYTES);
    (void)hipOccupancyMaxActiveBlocksPerMultiprocessor(&per_cu, mega, NT, LDS_BYTES);
    if (per_cu > 1) per_cu = 1;
    if (per_cu < 1) per_cu = 1;
    grid_blocks = cus * per_cu;
  }
  Params p{};
  for (int i = 0; i < 35; i++) p.in[i] = (const float*)d_in[i];
  p.out = (float*)d_out;
  p.ws = (char*)d_ws;
  (void)hipMemsetAsync((char*)d_ws + W_CNT, 0, 256 + al((size_t)XCD_BAR_WORDS * 4), stream);
  void* args[] = {&p};
  hipError_t e = hipLaunchCooperativeKernel((void*)mega, dim3(grid_blocks), dim3(NT), args, LDS_BYTES, stream);
  if (e != hipSuccess) fprintf(stderr, "cooperative launch failed: %s (grid %d)\n", hipGetErrorString(e), grid_blocks);
}
```
